# Optimizing an MI355X kernel written in HIP

```python
import jax
import jax.numpy as jnp
from jax import lax
import numpy as np

D_MODEL = 1024
BATCH = 8
SEQ = 4096
DEPTH = 4

GRID_W = 64
CTX_LEN = 256
N_Q_HEADS = 8
N_KV_HEADS = 2
HEAD_DIM = 64
Q_GROUP = N_Q_HEADS // N_KV_HEADS
WINDOW = 128
BLOCK = 128
ROPE_THETA = 10000.0
POOL_SIZES = (2, 4, 8, 16)
N_POOL_GROUPS = len(POOL_SIZES)
POOL_GROUP_DIM = D_MODEL // 8
POOL_WIDTH = N_POOL_GROUPS * POOL_GROUP_DIM
Q_WIDTH = N_Q_HEADS * HEAD_DIM
KV_WIDTH = N_KV_HEADS * HEAD_DIM
N_BRANCHES = 2
IN_WIDTH = Q_WIDTH + 2 * KV_WIDTH + POOL_WIDTH + N_BRANCHES * D_MODEL
D_FF = 2816
CONV_WIDTH = 3
N_MOD = 6
EPS = 1e-6
NEG_INF = -1e30

kernel_name = 'hybrid_dit_window_gqa_pool_convffn'


def rms_norm(x, g):
    xf = x.astype(jnp.float32)
    y = xf * lax.rsqrt(jnp.mean(xf * xf, axis=-1, keepdims=True) + EPS)
    return (y * g.astype(jnp.float32)).astype(x.dtype)


def modulate(x, g, shift, scale):
    return rms_norm(x, g) * (1 + scale) + shift


def adaln(cond, w_mod_l, b_mod_l):
    m = jax.nn.silu(cond) @ w_mod_l + b_mod_l
    return jnp.split(m, N_MOD, axis=-1)


def head_rms_norm(t, g):
    tf = t.astype(jnp.float32)
    y = tf * lax.rsqrt(jnp.mean(tf * tf, axis=-1, keepdims=True) + EPS)
    return (y * g.astype(jnp.float32)).astype(t.dtype)


def axial_rope_tables(rows):
    row = jnp.repeat(jnp.arange(rows, dtype=jnp.int32), GRID_W).astype(jnp.float32)
    col = jnp.tile(jnp.arange(GRID_W, dtype=jnp.int32), rows).astype(jnp.float32)
    n_freq = HEAD_DIM // 4
    inv = ROPE_THETA ** (-jnp.arange(n_freq, dtype=jnp.float32) / n_freq)
    ang = jnp.concatenate([row[:, None] * inv, col[:, None] * inv], axis=-1)
    return jnp.cos(ang), jnp.sin(ang)


def apply_axial_rope(t, cos, sin):
    B, N, H, _ = t.shape
    n_freq = HEAD_DIM // 4
    tf = t.astype(jnp.float32).reshape(B, N, H, 2, 2, n_freq)
    cb = cos.reshape(N, 2, n_freq)[None, :, None]
    sb = sin.reshape(N, 2, n_freq)[None, :, None]
    t1 = tf[..., 0, :]
    t2 = tf[..., 1, :]
    out = jnp.stack([t1 * cb - t2 * sb, t2 * cb + t1 * sb], axis=-2)
    return out.reshape(B, N, H, HEAD_DIM).astype(t.dtype)


def split_projection(z):
    B, N, _ = z.shape
    cuts = [Q_WIDTH, Q_WIDTH + KV_WIDTH, Q_WIDTH + 2 * KV_WIDTH, Q_WIDTH + 2 * KV_WIDTH + POOL_WIDTH]
    q, k, v, p, gate = jnp.split(z, cuts, axis=-1)
    q = q.reshape(B, N, N_Q_HEADS, HEAD_DIM)
    k = k.reshape(B, N, N_KV_HEADS, HEAD_DIM)
    v = v.reshape(B, N, N_KV_HEADS, HEAD_DIM)
    return q, k, v, p, gate


def windowed_attention(q, k, v, kc, vc, sink):
    B, N = q.shape[:2]
    nb = N // BLOCK
    scale = HEAD_DIM ** -0.5
    qb = q.reshape(B, nb, BLOCK, N_KV_HEADS, Q_GROUP, HEAD_DIM)
    pad = ((0, 0), (BLOCK, BLOCK), (0, 0), (0, 0))
    kp = jnp.pad(k, pad).reshape(B, nb + 2, BLOCK, N_KV_HEADS, HEAD_DIM)
    vp = jnp.pad(v, pad).reshape(B, nb + 2, BLOCK, N_KV_HEADS, HEAD_DIM)
    kb = jnp.concatenate([kp[:, :-2], kp[:, 1:-1], kp[:, 2:]], axis=2)
    vb = jnp.concatenate([vp[:, :-2], vp[:, 1:-1], vp[:, 2:]], axis=2)
    s_loc = jnp.einsum('bnqhgd,bnkhd->bnhgqk', qb, kb, preferred_element_type=jnp.float32) * scale
    s_ctx = jnp.einsum('bnqhgd,bchd->bnhgqc', qb, kc, preferred_element_type=jnp.float32) * scale
    blk = jnp.arange(nb)[:, None, None]
    qi = jnp.arange(BLOCK)[None, :, None]
    kj = jnp.arange(3 * BLOCK)[None, None, :]
    q_pos = blk * BLOCK + qi
    k_pos = (blk - 1) * BLOCK + kj
    valid = (jnp.abs(k_pos - q_pos) <= WINDOW) & (k_pos >= 0) & (k_pos < N)
    s_loc = jnp.where(valid[None, :, None, None], s_loc, NEG_INF)
    sink_b = sink.astype(jnp.float32).reshape(N_KV_HEADS, Q_GROUP)[None, None, :, :, None, None]
    m = jnp.maximum(jnp.maximum(jnp.max(s_loc, axis=-1, keepdims=True),
                                jnp.max(s_ctx, axis=-1, keepdims=True)), sink_b)
    e_loc = jnp.exp(s_loc - m)
    e_ctx = jnp.exp(s_ctx - m)
    denom = jnp.sum(e_loc, axis=-1, keepdims=True) + jnp.sum(e_ctx, axis=-1, keepdims=True) + jnp.exp(sink_b - m)
    o = (jnp.einsum('bnhgqk,bnkhd->bnhgqd', e_loc, vb.astype(jnp.float32))
         + jnp.einsum('bnhgqc,bchd->bnhgqd', e_ctx, vc.astype(jnp.float32))) / denom
    o = jnp.transpose(o, (0, 1, 4, 2, 3, 5))
    return o.reshape(B, N, Q_WIDTH).astype(q.dtype)


def context_attention(qc, kc, vc, sink):
    B, C = qc.shape[:2]
    scale = HEAD_DIM ** -0.5
    qg = qc.reshape(B, C, N_KV_HEADS, Q_GROUP, HEAD_DIM)
    s = jnp.einsum('bqhgd,bkhd->bhgqk', qg, kc, preferred_element_type=jnp.float32) * scale
    sink_b = jnp.broadcast_to(sink.astype(jnp.float32).reshape(N_KV_HEADS, Q_GROUP)[None, :, :, None, None],
                              s.shape[:-1] + (1,))
    p = jax.nn.softmax(jnp.concatenate([s, sink_b], axis=-1), axis=-1)[..., :-1]
    o = jnp.einsum('bhgqk,bkhd->bqhgd', p, vc.astype(jnp.float32))
    return o.reshape(B, C, Q_WIDTH).astype(qc.dtype)


def multiscale_pool(p):
    B, N, _ = p.shape
    pf = p.astype(jnp.float32)
    cs = jnp.concatenate([jnp.zeros((B, 1, POOL_WIDTH), jnp.float32), jnp.cumsum(pf, axis=1)], axis=1)
    pos = jnp.arange(N)
    outs = []
    for gi, w in enumerate(POOL_SIZES):
        cs_g = cs[..., gi * POOL_GROUP_DIM:(gi + 1) * POOL_GROUP_DIM]
        lo = jnp.clip(pos - w // 2, 0, N)
        hi = jnp.clip(pos + (w - w // 2), 0, N)
        s = jnp.take(cs_g, hi, axis=1) - jnp.take(cs_g, lo, axis=1)
        outs.append(s / (hi - lo).astype(jnp.float32)[None, :, None])
    pooled = jnp.concatenate(outs, axis=-1)
    return (pooled - pf).astype(p.dtype)


def pool_branch(p, w_pool_l, pool_scale_l):
    B, N, _ = p.shape
    d = multiscale_pool(p).reshape(B, N, N_POOL_GROUPS, POOL_GROUP_DIM)
    y = jnp.einsum('bngc,gcd->bngd', d, w_pool_l).reshape(B, N, POOL_WIDTH)
    return y * pool_scale_l


def merge_branches(attn, pool_out, gate, w_br_attn_l, w_br_pool_l, w_out_l):
    g = jax.nn.sigmoid(gate.astype(jnp.float32)).astype(attn.dtype)
    g_attn, g_pool = jnp.split(g, N_BRANCHES, axis=-1)
    y = g_attn * (attn @ w_br_attn_l) + g_pool * (pool_out @ w_br_pool_l)
    return y @ w_out_l


def conv_ffn(h, w_up_l, conv_w_l, conv_b_l, w_down_l):
    N = h.shape[1]
    u = h @ w_up_l
    half = CONV_WIDTH // 2
    up = jnp.pad(u, ((0, 0), (half, half), (0, 0)))
    uc = conv_b_l + up[:, 0:N] * conv_w_l[0]
    for j in range(1, CONV_WIDTH):
        uc = uc + up[:, j:j + N] * conv_w_l[j]
    a, b = jnp.split(uc, 2, axis=-1)
    return (jax.nn.silu(a) * b) @ w_down_l


def setup_inputs(seed: int = 0) -> dict:
    key = jax.random.key(seed)
    ks = jax.random.split(key, 24)
    f32 = jnp.float32
    D = D_MODEL

    def nrm(k, shape, s):
        return jax.random.normal(k, shape, f32) * s

    return {
        'x': nrm(ks[0], (BATCH, SEQ, D), 1.0),
        'c': nrm(ks[1], (BATCH, D), 1.0),
        'ctx': nrm(ks[2], (BATCH, CTX_LEN, D), 1.0),
        'c_ctx': nrm(ks[3], (D,), 1.0),
        'w_mod': nrm(ks[4], (DEPTH, D, N_MOD * D), 0.5 * D ** -0.5),
        'b_mod': nrm(ks[5], (DEPTH, N_MOD * D), 0.01),
        'norm1_g': 1.0 + nrm(ks[6], (DEPTH, D), 0.02),
        'norm2_g': 1.0 + nrm(ks[7], (DEPTH, D), 0.02),
        'w_in': nrm(ks[8], (DEPTH, D, IN_WIDTH), D ** -0.5),
        'q_gain': 1.0 + nrm(ks[9], (DEPTH, HEAD_DIM), 0.02),
        'k_gain': 1.0 + nrm(ks[10], (DEPTH, HEAD_DIM), 0.02),
        'sink': nrm(ks[11], (DEPTH, N_Q_HEADS), 0.5),
        'w_pool': nrm(ks[12], (DEPTH, N_POOL_GROUPS, POOL_GROUP_DIM, POOL_GROUP_DIM), POOL_GROUP_DIM ** -0.5),
        'pool_scale': 1.0 + nrm(ks[13], (DEPTH, POOL_WIDTH), 0.1),
        'w_br_attn': nrm(ks[14], (DEPTH, Q_WIDTH, D), Q_WIDTH ** -0.5),
        'w_br_pool': nrm(ks[15], (DEPTH, POOL_WIDTH, D), POOL_WIDTH ** -0.5),
        'w_out': nrm(ks[16], (DEPTH, D, D), D ** -0.5),
        'w_up': nrm(ks[17], (DEPTH, D, 2 * D_FF), D ** -0.5),
        'conv_w': nrm(ks[18], (DEPTH, CONV_WIDTH, 2 * D_FF), CONV_WIDTH ** -0.5),
        'conv_b': nrm(ks[19], (DEPTH, 2 * D_FF), 0.01),
        'w_down': nrm(ks[20], (DEPTH, D_FF, D), D_FF ** -0.5),
    }


def reference(x, c, ctx, c_ctx, w_mod, b_mod, norm1_g, norm2_g, w_in, q_gain, k_gain, sink,
              w_pool, pool_scale, w_br_attn, w_br_pool, w_out, w_up, conv_w, conv_b, w_down):
    B, n_tok = x.shape[0], x.shape[1]
    C = ctx.shape[1]
    rows = n_tok // GRID_W
    cos, sin = axial_rope_tables(rows)
    xc = ctx
    for l in range(DEPTH):
        last = l == DEPTH - 1
        sh1, sc1, g1, sh2, sc2, g2 = [t[:, None, :] for t in adaln(c, w_mod[l], b_mod[l])]
        csh1, csc1, cg1, csh2, csc2, cg2 = adaln(c_ctx, w_mod[l], b_mod[l])

        hc = modulate(xc, norm1_g[l], csh1, csc1)
        if last:
            kc, vc = jnp.split(hc @ w_in[l][:, Q_WIDTH:Q_WIDTH + 2 * KV_WIDTH], 2, axis=-1)
            kc = head_rms_norm(kc.reshape(B, C, N_KV_HEADS, HEAD_DIM), k_gain[l])
            vc = vc.reshape(B, C, N_KV_HEADS, HEAD_DIM)
        else:
            qc, kc, vc, pc, gatec = split_projection(hc @ w_in[l])
            qc = head_rms_norm(qc, q_gain[l])
            kc = head_rms_norm(kc, k_gain[l])
            mix_c = merge_branches(context_attention(qc, kc, vc, sink[l]),
                                   pool_branch(pc, w_pool[l], pool_scale[l]),
                                   gatec, w_br_attn[l], w_br_pool[l], w_out[l])
            xc_mid = xc + cg1 * mix_c
            xc_next = xc_mid + cg2 * conv_ffn(modulate(xc_mid, norm2_g[l], csh2, csc2),
                                              w_up[l], conv_w[l], conv_b[l], w_down[l])

        h = modulate(x, norm1_g[l], sh1, sc1)
        q, k, v, p, gate = split_projection(h @ w_in[l])
        q = apply_axial_rope(head_rms_norm(q, q_gain[l]), cos, sin)
        k = apply_axial_rope(head_rms_norm(k, k_gain[l]), cos, sin)
        attn = windowed_attention(q, k, v, kc, vc, sink[l])
        pool_out = pool_branch(p, w_pool[l], pool_scale[l])
        x = x + g1 * merge_branches(attn, pool_out, gate, w_br_attn[l], w_br_pool[l], w_out[l])

        x = x + g2 * conv_ffn(modulate(x, norm2_g[l], sh2, sc2), w_up[l], conv_w[l], conv_b[l], w_down[l])

        if not last:
            xc = xc_next
    return x
```

```cpp
#include <hip/hip_runtime.h>
#include <hip/hip_cooperative_groups.h>
#include <cstdio>
#include <cstdint>
namespace cg = cooperative_groups;

#ifndef DUPS
#define DUPS -1
#endif
#ifndef PHM
#define PHM 1023
#endif
#ifndef MULTI_LAUNCH
#define MULTI_LAUNCH 0
#endif

#define LAS __attribute__((address_space(3)))
typedef unsigned short bf16_t;
typedef short bf16x8 __attribute__((ext_vector_type(8)));
typedef float f32x4 __attribute__((ext_vector_type(4)));
typedef float f32x2 __attribute__((ext_vector_type(2)));
typedef unsigned u32x4 __attribute__((ext_vector_type(4)));
typedef unsigned u32x2 __attribute__((ext_vector_type(2)));

constexpr int D = 1024, NB = 8, SEQ = 4096, DEPTH = 4, CTX = 256;
constexpr int ML = NB * SEQ, MC = NB * CTX, MT = ML + MC;
constexpr int INW = 3328, DFF = 2816, UPW = 5632;
constexpr int ZLD = 1280;
constexpr size_t GATE_OFF = (size_t)(32768 + 2048) * ZLD * 2;
constexpr int ZK = 512, ZV = 640, ZP = 768, ZGA = 1280, ZGP = 2304;
constexpr int NMOD = 6 * D;
constexpr int PPL = 9 + (DUPS >= 0 ? 1 : 0);
constexpr int NPHASE = 1 + PPL * DEPTH;

constexpr size_t SZ_WIN = (size_t)INW * D * 2, SZ_WA = (size_t)D * 512 * 2, SZ_WE = SZ_WA, SZ_WO = (size_t)D * D * 2, SZ_WU = (size_t)UPW * D * 2, SZ_WD = (size_t)D * DFF * 2;
constexpr size_t OFF_WIN = 0, OFF_WA = OFF_WIN + SZ_WIN, OFF_WE = OFF_WA + SZ_WA, OFF_WO = OFF_WE + SZ_WE, OFF_WU = OFF_WO + SZ_WO, OFF_WD = OFF_WU + SZ_WU, SZ_WL = OFF_WD + SZ_WD;
constexpr size_t WS_W = 0;
constexpr size_t WS_MOD = WS_W + DEPTH * SZ_WL;
constexpr size_t WS_ROPE = WS_MOD + (size_t)DEPTH * 9 * NMOD * 4;
constexpr size_t WS_H = WS_ROPE + 64 * 16 * 8;
constexpr size_t WS_XC = WS_H + (size_t)MT * D * 2;
constexpr size_t WS_Z = WS_XC + (size_t)MC * D * 4;
constexpr size_t WS_AT = WS_Z + (size_t)MT * INW * 2;
constexpr size_t WS_PD = WS_AT + (size_t)MT * 512 * 2;
constexpr size_t WS_END = WS_PD + (size_t)MT * 512 * 2;
constexpr size_t WS_BAR = WS_END;
constexpr size_t WS_TOTAL = WS_BAR + 3456 * 4;
static_assert(WS_TOTAL <= (size_t)512 * 1024 * 1024, "workspace");
static_assert((size_t)272 * 4 * UPW * 4 <= (size_t)MT * 512 * 2, "ub overlay");

struct Args {
    const float* in[21];
    float* out;
    unsigned char* ws;
    int ph_lo, ph_hi;
};

struct Frame {
    const float *x, *c, *ctx, *c_ctx, *w_mod, *b_mod, *norm1_g, *norm2_g, *w_in, *q_gain, *k_gain, *sink, *w_pool, *pool_scale, *w_br_attn, *w_br_pool, *w_out, *w_up, *conv_w, *conv_b, *w_down;
    float* out; unsigned char* ws;
    float* mod; f32x2* rope; bf16_t* h; float* xc; bf16_t* z; bf16_t* at; bf16_t* pd; float* ub;
    LAS unsigned char* lds;
    int tid, G, bid;
};

__device__ __forceinline__ int fresh_tid(int wid) { int lane; asm volatile("v_mbcnt_lo_u32_b32 %0, -1, 0\n\tv_mbcnt_hi_u32_b32 %0, -1, %0" : "=v"(lane)); return wid * 64 + lane; }
__device__ __forceinline__ int opaque_v(int wid) { return fresh_tid(wid); }
__device__ __forceinline__ float bf2f(unsigned v) { return __uint_as_float(v << 16); }
__device__ __forceinline__ bf16_t f2bf(float f) { unsigned u = __float_as_uint(f); u += 0x7FFFu + ((u >> 16) & 1u); return (bf16_t)(u >> 16); }
__device__ __forceinline__ unsigned cvt_pk_bf16(float lo, float hi) { unsigned r; asm volatile("v_cvt_pk_bf16_f32 %0, %1, %2" : "=v"(r) : "v"(lo), "v"(hi)); return r; }
__device__ __forceinline__ float sigmoidf_(float x) { return __builtin_amdgcn_rcpf(1.0f + __expf(-x)); }

namespace pg8 {
constexpr int BM = 256, BK = 64, HALF = 128, HTB = HALF * BK * 2, STAGE_BYTES = 8 * HTB, NXCD = 8, WGM = 8;
__device__ __forceinline__ int lds_byte(int r, int c) { const int st = (r >> 4) * 2 + (c >> 5), rr = r & 15, cc = c & 31, ob = rr * 64 + cc * 2; return st * 1024 + (ob ^ (((ob >> 9) & 1) << 5)); }
__device__ __forceinline__ void stage_rc(int b, int& R, int& C) { const int st = b / 1024, sb = b % 1024, swz = sb ^ (((sb >> 9) & 1) << 5); R = (st >> 1) * 16 + swz / 64; C = (st & 1) * 32 + (swz % 64) / 2; }
__device__ __forceinline__ int perm32(int rho) { const int n = rho >> 4, i = rho & 15; return 8 * (i >> 2) + 4 * n + (i & 3); }

struct Unit { int pm, pn, which, kt0, ntu, ks; };

struct Sched {
    int nM, nN, nwg, G, c, pshift, nt, split;
    const char *A0, *A1, *B0, *B1; size_t tstepA, tstepB;
    __device__ __forceinline__ bool next(int i, Unit& u) const {
        const int ii = i >> pshift; u.which = i & ((1 << pshift) - 1); u.kt0 = 0; u.ntu = nt; u.ks = -1;
        if (split && i == 2) { const int cu = c >> 3, ks = c & 7, pairs = nt >> 1, base = pairs >> 3, rem = pairs & 7;
            u.pm = nM + (cu >> 2); u.pn = cu & 3; u.ks = ks; u.kt0 = 2 * (ks * base + (ks < rem ? ks : rem)); u.ntu = 2 * (base + (ks < rem ? 1 : 0)); return true; }
        const long L = (long)ii * G + c; if (L >= nwg) return false;
        int wgid = (int)L; { const int q = nwg / NXCD, r = nwg % NXCD, xcd = wgid % NXCD, off = wgid / NXCD; wgid = (xcd < r ? xcd * (q + 1) : r * (q + 1) + (xcd - r) * q) + off; }
        const int nig = WGM * nN, gid = wgid / nig, fm = gid * WGM, gsz = (nM - fm) < WGM ? (nM - fm) : WGM;
        u.pm = fm + ((wgid % nig) % gsz); u.pn = (wgid % nig) / gsz; return true;
    }
    __device__ __forceinline__ const char* a_base(const Unit& u) const { return (u.which ? A1 : A0) + (size_t)u.pm * tstepA + (size_t)u.kt0 * 128; }
    __device__ __forceinline__ const char* b_base(const Unit& u) const { return (u.which ? B1 : B0) + (size_t)u.pn * tstepB + (size_t)u.kt0 * 128; }
    __device__ __forceinline__ bool keep(const Unit& u) const { return pshift && u.which == 0; }
};

template <class Epi, bool ROWPERM>
__device__ __forceinline__ void gemm_phase(LAS unsigned char* lds, const int tid_in, const int K, const Sched& S, const Epi& E) {
    const int tid = opaque_v(tid_in);
    const int wid = __builtin_amdgcn_readfirstlane(tid >> 6), lane = tid & 63, wr = wid >> 2, wc = wid & 3, fr = lane & 15, fq = lane >> 4;
    unsigned voffA[2], voffB[2];
#pragma unroll
    for (int i = 0; i < 2; ++i) { int R, C; stage_rc(tid * 16 + i * 8192, R, C); const int Rb = Epi::PERM ? ((R & ~31) + perm32(R & 31)) : R;
        const int Ra = ROWPERM ? (128 * (R >> 6) + 8 * (R & 15) + ((R >> 4) & 3)) : R;
        voffA[i] = (unsigned)(Ra * K + C) * 2u; voffB[i] = (unsigned)(Rb * K + C) * 2u; }
    const size_t kstep = (size_t)(BK * 2);
    const size_t hstepB = (size_t)HALF * K * 2;
    const size_t hstepA = ROWPERM ? (size_t)4 * K * 2 : hstepB;
    const unsigned ldsw = (unsigned)wid * 1024u;
    const int aoff = lds_byte(wr * 64 + fr, fq * 8), boff = lds_byte(wc * 32 + fr, fq * 8);
#define PG8_SA(b, h) (((b) * 2 + (h)) * HTB)
#define PG8_SB(b, h) ((4 + (b) * 2 + (h)) * HTB)
#define PG8_STAGE(bufoff, gbase, voff) do { _Pragma("unroll") for (int _i = 0; _i < 2; ++_i) \
        __builtin_amdgcn_global_load_lds((const unsigned*)((const char*)(gbase) + (voff)[_i]), (LAS unsigned*)(lds + (bufoff) + ldsw + _i * 8192), 16, 0, 0); } while (0)
#define PG8_LDA(dst, b, h) do { _Pragma("unroll") for (int m = 0; m < 4; ++m) _Pragma("unroll") for (int k = 0; k < 2; ++k) dst[m][k] = *(const LAS bf16x8*)(lds + PG8_SA(b, h) + aoff + m * 2048 + k * 1024); } while (0)
#define PG8_LDB(dst, b, h) do { _Pragma("unroll") for (int n = 0; n < 2; ++n) _Pragma("unroll") for (int k = 0; k < 2; ++k) dst[n][k] = *(const LAS bf16x8*)(lds + PG8_SB(b, h) + boff + n * 2048 + k * 1024); } while (0)
#define PG8_MMA(ai, bj, At, Bt) do { __builtin_amdgcn_s_setprio(1); _Pragma("unroll") for (int m = 0; m < 4; ++m) _Pragma("unroll") for (int n = 0; n < 2; ++n) _Pragma("unroll") for (int k = 0; k < 2; ++k) \
        acc[ai][bj][m][n] = __builtin_amdgcn_mfma_f32_16x16x32_bf16(Bt[n][k], At[m][k], acc[ai][bj][m][n], 0, 0, 0); __builtin_amdgcn_s_setprio(0); } while (0)
#define PG8_WAIT_V(n) asm volatile("s_waitcnt vmcnt(" #n ")" ::: "memory")
#define PG8_WAIT_L(n) asm volatile("s_waitcnt lgkmcnt(" #n ")" ::: "memory")
#define PG8_BAR __builtin_amdgcn_s_barrier()
#define PG8_SCHED __builtin_amdgcn_sched_barrier(0)
    Unit cur, nxt; int ui = 0;
    if (!S.next(0, cur)) return;
    f32x4 acc[2][2][4][2];
#pragma unroll
    for (int a = 0; a < 2; ++a)
#pragma unroll
        for (int b = 0; b < 2; ++b)
#pragma unroll
            for (int m = 0; m < 4; ++m)
#pragma unroll
                for (int n = 0; n < 2; ++n) acc[a][b][m][n] = (f32x4){0.f, 0.f, 0.f, 0.f};
    bf16x8 At[4][2], B0[2][2], B1[2][2];
    const char* cA = S.a_base(cur); const char* cB = S.b_base(cur);
    PG8_STAGE(PG8_SB(0, 0), cB, voffB); PG8_STAGE(PG8_SA(0, 0), cA, voffA); PG8_STAGE(PG8_SB(0, 1), cB + hstepB, voffB); PG8_STAGE(PG8_SA(0, 1), cA + hstepA, voffA);
    if (wr == 1) PG8_BAR;
    PG8_WAIT_V(4); PG8_BAR;
    PG8_STAGE(PG8_SB(1, 0), cB + kstep, voffB); PG8_STAGE(PG8_SA(1, 0), cA + kstep, voffA); PG8_STAGE(PG8_SB(1, 1), cB + hstepB + kstep, voffB);
    PG8_WAIT_V(6); PG8_BAR;
    for (;;) {
        const bool has_next = S.next(ui + 1, nxt);
        const char* nA = has_next ? S.a_base(nxt) : cA; const char* nB = has_next ? S.b_base(nxt) : cB;
        const int ntc = cur.ntu;
        for (int t = 0; t < ntc; t += 2) {
            const bool last = (t == ntc - 2);
            const char* a1 = cA + (size_t)(t + 1) * kstep;
            const char* a2 = last ? nA : cA + (size_t)(t + 2) * kstep; const char* b2 = last ? nB : cB + (size_t)(t + 2) * kstep;
            const char* a3 = a2 + kstep; const char* b3 = b2 + kstep;
            PG8_LDB(B0, 0, 0); PG8_SCHED; PG8_LDA(At, 0, 0); PG8_STAGE(PG8_SA(1, 1), a1 + hstepA, voffA);
            PG8_WAIT_L(8); PG8_BAR; PG8_WAIT_L(0); PG8_MMA(0, 0, At, B0); PG8_BAR; PG8_SCHED;
            PG8_LDB(B1, 0, 1); PG8_STAGE(PG8_SB(0, 0), b2, voffB);
            PG8_BAR; PG8_WAIT_L(0); PG8_MMA(0, 1, At, B1); PG8_BAR;
            PG8_LDA(At, 0, 1); PG8_STAGE(PG8_SA(0, 0), a2, voffA);
            PG8_BAR; PG8_WAIT_L(0); PG8_MMA(1, 0, At, B0); PG8_BAR; PG8_SCHED;
            PG8_STAGE(PG8_SB(0, 1), b2 + hstepB, voffB);
            PG8_WAIT_V(6); PG8_BAR; PG8_MMA(1, 1, At, B1); PG8_BAR;
            PG8_LDB(B0, 1, 0); PG8_SCHED; PG8_LDA(At, 1, 0); PG8_STAGE(PG8_SA(0, 1), a2 + hstepA, voffA);
            PG8_WAIT_L(8); PG8_BAR; PG8_WAIT_L(0); PG8_MMA(0, 0, At, B0); PG8_BAR; PG8_SCHED;
            PG8_LDB(B1, 1, 1); PG8_STAGE(PG8_SB(1, 0), b3, voffB);
            PG8_BAR; PG8_WAIT_L(0); PG8_MMA(0, 1, At, B1); PG8_BAR;
            PG8_LDA(At, 1, 1); PG8_STAGE(PG8_SA(1, 0), a3, voffA);
            PG8_BAR; PG8_WAIT_L(0); PG8_MMA(1, 0, At, B0); PG8_BAR; PG8_SCHED;
            PG8_STAGE(PG8_SB(1, 1), b3 + hstepB, voffB);
            PG8_WAIT_V(6); PG8_BAR; PG8_MMA(1, 1, At, B1); PG8_BAR;
        }
        E(acc, cur, wr, wc, fr, fq);
        if (!has_next) break;
        if (!S.keep(cur)) {
#pragma unroll
            for (int a = 0; a < 2; ++a)
#pragma unroll
                for (int b = 0; b < 2; ++b)
#pragma unroll
                    for (int m = 0; m < 4; ++m)
#pragma unroll
                        for (int n = 0; n < 2; ++n) acc[a][b][m][n] = (f32x4){0.f, 0.f, 0.f, 0.f};
        }
        cur = nxt; cA = nA; cB = nB; ++ui;
    }
    PG8_WAIT_V(0);
    if (wr == 0) PG8_BAR;
    PG8_BAR;
#undef PG8_SA
#undef PG8_SB
#undef PG8_STAGE
#undef PG8_LDA
#undef PG8_LDB
#undef PG8_MMA
#undef PG8_WAIT_V
#undef PG8_WAIT_L
#undef PG8_BAR
#undef PG8_SCHED
}

struct EpiZ {
    static constexpr bool PERM = true;
    bf16_t* O;
    __device__ __forceinline__ void operator()(f32x4 (&acc)[2][2][4][2], const Unit& u, int wr, int wc, int fr_, int fq_) const {
        (void)fr_; (void)fq_; const int lane_e = fresh_tid(0); const int fr = lane_e & 15, fq = lane_e >> 4;
        const int row0 = u.pm * BM + wr * 64 + fr, col0 = u.pn * BM + wc * 32 + 8 * fq;
        if (u.pn >= 5) {
            const int gt = (u.pn - 5) >> 2, pq = (u.pn - 5) & 3;
            unsigned char* gb = (unsigned char*)O + GATE_OFF + ((size_t)((gt * 136 + u.pm) * 4 + pq) * 16 * 8 + (wr * 4 + wc)) * 1024 + lane_e * 16;
#pragma unroll
            for (int ai = 0; ai < 2; ++ai)
#pragma unroll
                for (int m = 0; m < 4; ++m)
#pragma unroll
                    for (int bj = 0; bj < 2; ++bj) { const f32x4 v0 = acc[ai][bj][m][0], v1 = acc[ai][bj][m][1];
                        u32x4 w; w.x = cvt_pk_bf16(v0[0], v0[1]); w.y = cvt_pk_bf16(v0[2], v0[3]); w.z = cvt_pk_bf16(v1[0], v1[1]); w.w = cvt_pk_bf16(v1[2], v1[3]);
                        *(u32x4*)(gb + (size_t)((ai * 4 + m) * 2 + bj) * 8 * 1024) = w; }
            return;
        }
#pragma unroll
        for (int ai = 0; ai < 2; ++ai)
#pragma unroll
            for (int m = 0; m < 4; ++m) { bf16_t* rowp = O + (size_t)(row0 + ai * HALF + m * 16) * ZLD + col0;
#pragma unroll
                for (int bj = 0; bj < 2; ++bj) { const f32x4 v0 = acc[ai][bj][m][0], v1 = acc[ai][bj][m][1];
                    u32x4 w; w.x = cvt_pk_bf16(v0[0], v0[1]); w.y = cvt_pk_bf16(v0[2], v0[3]); w.z = cvt_pk_bf16(v1[0], v1[1]); w.w = cvt_pk_bf16(v1[2], v1[3]);
                    *(u32x4*)(rowp + bj * HALF) = w; } }
    }
};

struct EpiMerge {
    static constexpr bool PERM = true;
    const bf16_t* z; bf16_t* y;
    __device__ __forceinline__ void operator()(f32x4 (&acc)[2][2][4][2], const Unit& u, int wr, int wc, int fr_, int fq_) const {
        (void)fr_; (void)fq_; const int lane_e = fresh_tid(0); const int fr = lane_e & 15, fq = lane_e >> 4;
        const int row0 = u.pm * BM + wr * 64 + fr, col0 = u.pn * BM + wc * 32 + 8 * fq;
        const unsigned char* gb = (const unsigned char*)z + GATE_OFF + ((size_t)(u.pm * 4 + u.pn) * 16 * 8 + (wr * 4 + wc)) * 1024 + (fq * 16 + fr) * 16;
#pragma unroll
        for (int ai = 0; ai < 2; ++ai) {
            u32x4 gpv[4][2], gav[4][2];
#pragma unroll
            for (int m = 0; m < 4; ++m)
#pragma unroll
                for (int bj = 0; bj < 2; ++bj) gpv[m][bj] = *(const u32x4*)(gb + (size_t)(136 * 4 * 16 * 8) * 1024 + (size_t)((ai * 4 + m) * 2 + bj) * 8 * 1024);
            if (u.which == 0) {
#pragma unroll
                for (int m = 0; m < 4; ++m)
#pragma unroll
                    for (int bj = 0; bj < 2; ++bj) gav[m][bj] = *(const u32x4*)(gb + (size_t)((ai * 4 + m) * 2 + bj) * 8 * 1024);
            }
#pragma unroll
            for (int m = 0; m < 4; ++m) { const size_t row = (size_t)(row0 + ai * HALF + m * 16);
#pragma unroll
                for (int bj = 0; bj < 2; ++bj) { const int col = col0 + bj * HALF;
                    const u32x4 gp = gpv[m][bj];
                    float ep[8];
#pragma unroll
                    for (int e = 0; e < 4; ++e) { const float lo = bf2f(gp[e] & 0xffffu), hi = bf2f(gp[e] >> 16);
                        ep[2 * e] = __builtin_amdgcn_exp2f(__builtin_amdgcn_fmed3f(lo * -1.44269504f, -43.f, 43.f)); ep[2 * e + 1] = __builtin_amdgcn_exp2f(__builtin_amdgcn_fmed3f(hi * -1.44269504f, -43.f, 43.f)); }
                    if (u.which == 0) {
                        const u32x4 ga = gav[m][bj];
#pragma unroll
                        for (int e = 0; e < 4; ++e) { const float lo = bf2f(ga[e] & 0xffffu), hi = bf2f(ga[e] >> 16);
                            const float ea0 = __builtin_amdgcn_exp2f(__builtin_amdgcn_fmed3f(lo * -1.44269504f, -43.f, 43.f)), ea1 = __builtin_amdgcn_exp2f(__builtin_amdgcn_fmed3f(hi * -1.44269504f, -43.f, 43.f));
                            const float r0 = (1.0f + ep[2 * e]) * __builtin_amdgcn_rcpf(1.0f + ea0), r1 = (1.0f + ep[2 * e + 1]) * __builtin_amdgcn_rcpf(1.0f + ea1);
                            acc[ai][bj][m][e >> 1][(2 * e) & 3] *= r0; acc[ai][bj][m][e >> 1][(2 * e + 1) & 3] *= r1; }
                    } else {
                        float o[8];
#pragma unroll
                        for (int e = 0; e < 8; ++e) o[e] = acc[ai][bj][m][e >> 2][e & 3] * __builtin_amdgcn_rcpf(1.0f + ep[e]);
                        u32x4 w; w.x = cvt_pk_bf16(o[0], o[1]); w.y = cvt_pk_bf16(o[2], o[3]); w.z = cvt_pk_bf16(o[4], o[5]); w.w = cvt_pk_bf16(o[6], o[7]);
                        *(u32x4*)(y + row * D + col) = w;
                    } } }
            asm volatile("" ::: "memory");
        }
    }
};

struct EpiRes {
    static constexpr bool PERM = false;
    const float *xl_in, *xc_in; float *xl_out, *xc_out; const float* modl; float* P; int goff;
    __device__ __forceinline__ void operator()(f32x4 (&acc)[2][2][4][2], const Unit& u, int wr, int wc, int fr_, int fq_) const {
        (void)fr_; (void)fq_; const int lane_e = fresh_tid(0); const int fr = lane_e & 15, fq = lane_e >> 4;
        const bool lat = u.pm < ML / BM;
        const int rbase = (lat ? u.pm * BM : u.pm * BM - ML) + wr * 64 + fr;
        const float* xin = lat ? xl_in : xc_in; float* xout = lat ? xl_out : xc_out;
        const float* gv = modl + (size_t)(lat ? (u.pm >> 4) : 8) * NMOD + goff;
        const int col0 = u.pn * BM + wc * 32 + 4 * fq;
        f32x4 g[2][2];
#pragma unroll
        for (int bj = 0; bj < 2; ++bj)
#pragma unroll
            for (int n = 0; n < 2; ++n) g[bj][n] = *(const f32x4*)(gv + col0 + bj * HALF + n * 16);
        if (u.ks >= 0) {
            float* pp = P + ((size_t)u.ks * MC + rbase) * D + col0;
#pragma unroll
            for (int ai = 0; ai < 2; ++ai)
#pragma unroll
                for (int m = 0; m < 4; ++m)
#pragma unroll
                    for (int bj = 0; bj < 2; ++bj)
#pragma unroll
                        for (int n = 0; n < 2; ++n) *(f32x4*)(pp + (size_t)(ai * HALF + m * 16) * D + bj * HALF + n * 16) = g[bj][n] * acc[ai][bj][m][n];
            return;
        }
#pragma unroll
        for (int ai = 0; ai < 2; ++ai) {
            f32x4 xi[4][2][2];
#pragma unroll
            for (int m = 0; m < 4; ++m) { const size_t off = (size_t)(rbase + ai * HALF + m * 16) * D + col0;
#pragma unroll
                for (int bj = 0; bj < 2; ++bj)
#pragma unroll
                    for (int n = 0; n < 2; ++n) xi[m][bj][n] = *(const f32x4*)(xin + off + bj * HALF + n * 16); }
#pragma unroll
            for (int m = 0; m < 4; ++m) { const size_t off = (size_t)(rbase + ai * HALF + m * 16) * D + col0;
#pragma unroll
                for (int bj = 0; bj < 2; ++bj)
#pragma unroll
                    for (int n = 0; n < 2; ++n) *(f32x4*)(xout + off + bj * HALF + n * 16) = xi[m][bj][n] + g[bj][n] * acc[ai][bj][m][n]; }
            asm volatile("" ::: "memory");
        }
    }
};

struct EpiUp {
    static constexpr bool PERM = true;
    bf16_t* act; float* ub; const float* cw; const float* cb;
    __device__ __forceinline__ void operator()(f32x4 (&acc)[2][2][4][2], const Unit& u, int wr, int wc, int fr_, int fq_) const {
        (void)fr_; (void)fq_; const int lane_e = fresh_tid(0); const int fr = lane_e & 15, fq = lane_e >> 4;
        const int lane = fq * 16 + fr;
        const int srcU = (lane & 48) | ((fr + 15) & 15), srcD = (lane & 48) | ((fr + 1) & 15);
        const int grp = 2 * u.pm + wr;
        const size_t tok0 = (size_t)grp * 128;
        if (fr == 0) {
#pragma unroll
            for (int n = 0; n < 2; ++n) { float* p = ub + ((size_t)(grp * 4) * 2) * DFF + 128 * u.pn + 32 * wc + 8 * fq + 4 * n;
                *(f32x4*)p = acc[0][0][0][n]; *(f32x4*)(p + DFF) = acc[0][1][0][n]; *(f32x4*)(p + 2 * DFF) = acc[0][0][1][n]; *(f32x4*)(p + 3 * DFF) = acc[0][1][1][n]; }
        }
        if (fr == 15) {
#pragma unroll
            for (int n = 0; n < 2; ++n) { float* p = ub + ((size_t)(grp * 4 + 2) * 2) * DFF + 128 * u.pn + 32 * wc + 8 * fq + 4 * n;
                *(f32x4*)p = acc[1][0][2][n]; *(f32x4*)(p + DFF) = acc[1][1][2][n]; *(f32x4*)(p + 2 * DFF) = acc[1][0][3][n]; *(f32x4*)(p + 3 * DFF) = acc[1][1][3][n]; }
        }
        u32x2 keep[8];
#pragma unroll
        for (int n = 0; n < 2; ++n) {
            const int ch = 128 * u.pn + 32 * wc + 8 * fq + 4 * n;
            const f32x4 w0a = *(const f32x4*)(cw + ch), w1a = *(const f32x4*)(cw + UPW + ch), w2a = *(const f32x4*)(cw + 2 * UPW + ch), cba = *(const f32x4*)(cb + ch);
            const f32x4 w0b = *(const f32x4*)(cw + DFF + ch), w1b = *(const f32x4*)(cw + UPW + DFF + ch), w2b = *(const f32x4*)(cw + 2 * UPW + DFF + ch), cbb = *(const f32x4*)(cb + DFF + ch);
            f32x4 hua, hub, hda, hdb;
            { const f32x4 la = acc[1][0][3][n], lb = acc[1][1][3][n], fa = acc[0][0][0][n], fb = acc[0][1][0][n];
#pragma unroll
              for (int j = 0; j < 4; ++j) { hua[j] = __shfl(la[j], srcU); hub[j] = __shfl(lb[j], srcU); hda[j] = __shfl(fa[j], srcD); hdb[j] = __shfl(fb[j], srcD); } }
#pragma unroll
            for (int q = 0; q < 8; ++q) {
                const int ai = q >> 2, m = q & 3;
                const f32x4 ca = acc[ai][0][m][n], cbv = acc[ai][1][m][n];
                const f32x4 upa = q > 0 ? acc[(q - 1) >> 2][0][(q - 1) & 3][n] : hua, upb = q > 0 ? acc[(q - 1) >> 2][1][(q - 1) & 3][n] : hub;
                const f32x4 dna = q < 7 ? acc[(q + 1) >> 2][0][(q + 1) & 3][n] : hda, dnb = q < 7 ? acc[(q + 1) >> 2][1][(q + 1) & 3][n] : hdb;
                const f32x4 ua = cba + w0a * upa + w1a * ca + w2a * dna, uv = cbb + w0b * upb + w1b * cbv + w2b * dnb;
                const int g = 8 * fr + q;
                float o[4];
#pragma unroll
                for (int j = 0; j < 4; ++j) o[j] = ua[j] * sigmoidf_(ua[j]) * uv[j];
                u32x2 w; w.x = cvt_pk_bf16(o[0], o[1]); w.y = cvt_pk_bf16(o[2], o[3]);
                if (n == 0) keep[q] = w;
                else if (g != 0 && g != 127) { u32x4 ww; ww.x = keep[q].x; ww.y = keep[q].y; ww.z = w.x; ww.w = w.y; *(u32x4*)(act + (tok0 + g) * DFF + ch - 4) = ww; }
            }
        }
    }
};
}

__device__ __forceinline__ void transpose_tile(const Frame& F, const float* src, int K, int N, bf16_t* dst, int k0, int n0, bool upperm) {
    LAS bf16_t* T = (LAS bf16_t*)F.lds;
    const int t = opaque_v(F.tid);
    { const int kk = t >> 3, nc = (t & 7) * 8;
      const float* p = src + (size_t)(k0 + kk) * N + n0 + nc;
      f32x4 a[4], b[4];
#pragma unroll
      for (int sb = 0; sb < 4; ++sb) { a[sb] = *(const f32x4*)(p + sb * 64); b[sb] = *(const f32x4*)(p + sb * 64 + 4); }
#pragma unroll
      for (int sb = 0; sb < 4; ++sb)
#pragma unroll
        for (int i = 0; i < 4; ++i) { T[(sb * 64 + nc + i) * 66 + kk] = f2bf(a[sb][i]); T[(sb * 64 + nc + 4 + i) * 66 + kk] = f2bf(b[sb][i]); } }
    __syncthreads();
#pragma unroll
    for (int sb = 0; sb < 4; ++sb) { const int nn = sb * 64 + (t >> 3), kc = (t & 7) * 8;
      const LAS unsigned* q = (const LAS unsigned*)(T + nn * 66 + kc);
      u32x4 w; w.x = q[0]; w.y = q[1]; w.z = q[2]; w.w = q[3];
      int n = n0 + nn;
      if (upperm) { const int half = n / DFF, chn = n % DFF; n = 256 * (chn >> 7) + 128 * half + (chn & 127); }
      *(u32x4*)(dst + (size_t)n * K + k0 + kc) = w; }
    __syncthreads();
}

__device__ void prologue(const Frame& F) {
    const int t = opaque_v(F.tid);
    constexpr int T_IN = 16 * 13, T_A = 8 * 4, T_O = 16 * 4, T_U = 16 * 22, T_D = 44 * 4, T_L = T_IN + T_A + T_O + T_U + T_D;
    for (int T = F.bid; T < DEPTH * T_L; T += F.G) {
        const int l = T / T_L; int r = T % T_L;
        unsigned char* wl = F.ws + WS_W + (size_t)l * SZ_WL;
        if (r < T_IN) { transpose_tile(F, F.w_in + (size_t)l * D * INW, D, INW, (bf16_t*)(wl + OFF_WIN), (r / 13) * 64, (r % 13) * 256, false); continue; } r -= T_IN;
        if (r < T_A) { transpose_tile(F, F.w_br_attn + (size_t)l * 512 * D, 512, D, (bf16_t*)(wl + OFF_WA), (r / 4) * 64, (r % 4) * 256, false); continue; } r -= T_A;
        if (r < T_O) { transpose_tile(F, F.w_out + (size_t)l * D * D, D, D, (bf16_t*)(wl + OFF_WO), (r / 4) * 64, (r % 4) * 256, false); continue; } r -= T_O;
        if (r < T_U) { transpose_tile(F, F.w_up + (size_t)l * D * UPW, D, UPW, (bf16_t*)(wl + OFF_WU), (r / 22) * 64, (r % 22) * 256, true); continue; } r -= T_U;
        transpose_tile(F, F.w_down + (size_t)l * DFF * D, DFF, D, (bf16_t*)(wl + OFF_WD), (r / 4) * 64, (r % 4) * 256, false);
    }
    for (int it = F.bid; it < DEPTH * 256; it += F.G) {
        const int idx = it * 512 + t, n = (idx & 255) * 4, gc = (idx >> 8) & 511, l = idx >> 17, g = gc >> 7;
        const float* wp = F.w_pool + ((size_t)l * 512 + gc) * 128;
        const float* ps = F.pool_scale + (size_t)l * 512 + g * 128;
        const float* wb = F.w_br_pool + ((size_t)l * 512 + g * 128) * D + n;
        f32x4 s4 = (f32x4){0.f, 0.f, 0.f, 0.f};
#pragma unroll 8
        for (int d = 0; d < 128; ++d) s4 += (wp[d] * ps[d]) * *(const f32x4*)(wb + (size_t)d * D);
        bf16_t* o = (bf16_t*)(F.ws + WS_W + (size_t)l * SZ_WL + OFF_WE) + (size_t)n * 512 + gc;
        o[0] = f2bf(s4[0]); o[512] = f2bf(s4[1]); o[1024] = f2bf(s4[2]); o[1536] = f2bf(s4[3]);
    }
    {
        LAS float* sc = (LAS float*)F.lds;
        LAS float* red = sc + 9 * 1024;
        for (int it = F.bid; it < DEPTH * 64; it += F.G) {
            const int l = it >> 6, n0 = (it & 63) * 96;
            __syncthreads();
            for (int e = t; e < 9 * 1024; e += 512) { const int i = e >> 10, k = e & 1023; const float v = i < 8 ? F.c[i * D + k] : F.c_ctx[k]; sc[e] = v * sigmoidf_(v); }
            __syncthreads();
            if (t < 384) {
                const int col = t % 96, kg = t / 96;
                const float* w = F.w_mod + (size_t)l * D * NMOD + (size_t)(kg * 256) * NMOD + n0 + col;
                float a0 = 0, a1 = 0, a2 = 0, a3 = 0, a4 = 0, a5 = 0, a6 = 0, a7 = 0, a8 = 0;
#pragma unroll 8
                for (int k = 0; k < 256; ++k) { const float wv = w[(size_t)k * NMOD]; const LAS float* s = sc + kg * 256 + k;
                    a0 += s[0] * wv; a1 += s[1024] * wv; a2 += s[2048] * wv; a3 += s[3072] * wv; a4 += s[4096] * wv; a5 += s[5120] * wv; a6 += s[6144] * wv; a7 += s[7168] * wv; a8 += s[8192] * wv; }
                LAS float* r = red + kg * 9 * 96 + col;
                r[0] = a0; r[96] = a1; r[192] = a2; r[288] = a3; r[384] = a4; r[480] = a5; r[576] = a6; r[672] = a7; r[768] = a8;
            }
            __syncthreads();
            for (int e = t; e < 9 * 96; e += 512) { const int i = e / 96, col = e % 96;
                const float v = red[e] + red[864 + e] + red[1728 + e] + red[2592 + e] + F.b_mod[(size_t)l * NMOD + n0 + col];
                F.mod[((size_t)l * 9 + i) * NMOD + n0 + col] = v; }
        }
        __syncthreads();
    }
    if (F.bid == (F.G > 1 ? 1 : 0)) {
        for (int e = t; e < 1024; e += 512) {
            const int pos = e >> 4, f = e & 15;
            double inv = 1.0; for (int i = 0; i < f; ++i) inv *= 0.56234132519034908;
            double cs = 1.0, sn = inv, term_c = 1.0, term_s = inv; const double x2 = inv * inv;
            for (int k = 1; k < 14; ++k) { term_c *= -x2 / (double)((2 * k - 1) * (2 * k)); term_s *= -x2 / (double)((2 * k) * (2 * k + 1)); cs += term_c; sn += term_s; }
            double cr = 1.0, sr = 0.0;
            for (int i = 0; i < pos; ++i) { const double c2 = cr * cs - sr * sn, s2 = sr * cs + cr * sn; cr = c2; sr = s2; }
            F.rope[e] = (f32x2){(float)cr, (float)sr};
        }
    }
}

__device__ void norm_phase(const Frame& F, const float* xl, const float* xc, const float* gvec, const float* modl, int shoff, int scoff, const float* P) {
    const int tidn = opaque_v(F.tid); const int lane = tidn & 63, wv = tidn >> 6;
    const int stride = F.G * 8;
    int row = F.bid * 8 + wv;
    f32x4 nx[4], nsc[4], nsh[4], g[4];
#pragma unroll
    for (int j = 0; j < 4; ++j) g[j] = *(const f32x4*)(gvec + j * 256 + lane * 4);
    if (row < MT) { const float* src = row < ML ? xl + (size_t)row * D : xc + (size_t)(row - ML) * D; const float* mv0 = modl + (size_t)(row < ML ? (row >> 12) : 8) * NMOD;
#pragma unroll
        for (int j = 0; j < 4; ++j) { nx[j] = *(const f32x4*)(src + j * 256 + lane * 4); nsc[j] = *(const f32x4*)(mv0 + scoff + j * 256 + lane * 4); nsh[j] = *(const f32x4*)(mv0 + shoff + j * 256 + lane * 4); } }
    while (row < MT) {
        const bool lat = row < ML;
        const float* mv = modl + (size_t)(lat ? (row >> 12) : 8) * NMOD;
        f32x4 v[4], sc[4], sh[4];
#pragma unroll
        for (int j = 0; j < 4; ++j) { v[j] = nx[j]; sc[j] = nsc[j]; sh[j] = nsh[j]; }
        const int rown = row + stride;
        if (rown < MT) { const float* src = rown < ML ? xl + (size_t)rown * D : xc + (size_t)(rown - ML) * D; const float* mvn = modl + (size_t)(rown < ML ? (rown >> 12) : 8) * NMOD;
#pragma unroll
            for (int j = 0; j < 4; ++j) { nx[j] = *(const f32x4*)(src + j * 256 + lane * 4); nsc[j] = *(const f32x4*)(mvn + scoff + j * 256 + lane * 4); nsh[j] = *(const f32x4*)(mvn + shoff + j * 256 + lane * 4); } }
        if (P && !lat) {
#pragma unroll
            for (int j = 0; j < 4; ++j) { const float* pr = P + (size_t)(row - ML) * D + j * 256 + lane * 4;
#pragma unroll
                for (int k = 0; k < 8; ++k) v[j] += *(const f32x4*)(pr + (size_t)k * MC * D);
                *(f32x4*)(F.xc + (size_t)(row - ML) * D + j * 256 + lane * 4) = v[j]; }
        }
        float ss = 0.f;
#pragma unroll
        for (int j = 0; j < 4; ++j) ss += v[j][0] * v[j][0] + v[j][1] * v[j][1] + v[j][2] * v[j][2] + v[j][3] * v[j][3];
#pragma unroll
        for (int o = 32; o >= 1; o >>= 1) ss += __shfl_xor(ss, o);
        const float rstd = rsqrtf(ss * (1.0f / D) + 1e-6f);
#pragma unroll
        for (int j = 0; j < 4; ++j) { const int col = j * 256 + lane * 4;
            const f32x4 y = v[j] * rstd * g[j] * (1.0f + sc[j]) + sh[j];
            u32x2 w; w.x = cvt_pk_bf16(y[0], y[1]); w.y = cvt_pk_bf16(y[2], y[3]);
            *(u32x2*)(F.h + (size_t)row * D + col) = w; }
        row = rown;
    }
}

template <int W2>
__device__ __forceinline__ void pooldiff_item(const Frame& F, int tok0, int col) {
    int s0, len;
    if (tok0 < ML) { s0 = tok0 & ~(SEQ - 1); len = SEQ; } else { s0 = ML + ((tok0 - ML) & ~(CTX - 1)); len = CTX; }
    const int tt0 = tok0 - s0;
    constexpr int NR = 8 + 2 * W2;
    u32x4 v[NR];
#pragma unroll
    for (int r = 0; r < NR; ++r) { int rr = tt0 - W2 + r; rr = rr < 0 ? 0 : (rr >= len ? len - 1 : rr); v[r] = *(const u32x4*)(F.z + (size_t)(s0 + rr) * ZLD + ZP + col); }
#pragma unroll
    for (int i = 0; i < 8; ++i) {
        float s[8];
#pragma unroll
        for (int e = 0; e < 8; ++e) s[e] = 0.f;
#pragma unroll
        for (int r = i; r < i + 2 * W2; ++r) { const int rr = tt0 - W2 + r; const float wgt = (rr >= 0 && rr < len) ? 1.0f : 0.0f;
#pragma unroll
            for (int e = 0; e < 4; ++e) { s[2 * e] += wgt * bf2f(v[r][e] & 0xffffu); s[2 * e + 1] += wgt * bf2f(v[r][e] >> 16); } }
        const int tt = tt0 + i, lo = max(tt - W2, 0), hi = min(tt + W2, len);
        const float inv = 1.0f / (float)(hi - lo);
        const u32x4 me = v[i + W2];
        float o[8];
#pragma unroll
        for (int e = 0; e < 4; ++e) { o[2 * e] = s[2 * e] * inv - bf2f(me[e] & 0xffffu); o[2 * e + 1] = s[2 * e + 1] * inv - bf2f(me[e] >> 16); }
        u32x4 w; w.x = cvt_pk_bf16(o[0], o[1]); w.y = cvt_pk_bf16(o[2], o[3]); w.z = cvt_pk_bf16(o[4], o[5]); w.w = cvt_pk_bf16(o[6], o[7]);
        *(u32x4*)(F.pd + (size_t)(tok0 + i) * 512 + col) = w;
    }
}
__device__ void pooldiff_phase(const Frame& F, int mrows) {
    const int vcp = (F.G % 8 == 0) ? (F.bid % 8) * (F.G / 8) + F.bid / 8 : F.bid;
    for (int it = vcp; it < (mrows / 256) * 4; it += F.G) {
        const int tidp = opaque_v(F.tid);
        const int gi = ((it & 3) + ((F.G & 3) == 0 ? it / F.G : 0)) & 3, tok0 = (it >> 2) * 256 + (tidp >> 4) * 8, col = gi * 128 + (tidp & 15) * 8;
        if (gi == 0) pooldiff_item<1>(F, tok0, col); else if (gi == 1) pooldiff_item<2>(F, tok0, col); else if (gi == 2) pooldiff_item<4>(F, tok0, col); else pooldiff_item<8>(F, tok0, col);
    }
}

__device__ void attn_unit(const Frame& F, int l, bool isctx, int b, int qblk, int hk) {
    const int tid = opaque_v(F.tid), lane = tid & 63, wv = tid >> 6, fr = lane & 15, fq = lane >> 4;
    const int g = wv >> 1, qh = wv & 1, hq = hk * 4 + g;
    LAS unsigned char* Kb = F.lds;
    LAS bf16_t* Vt = (LAS bf16_t*)(F.lds + 64 * 144);
    const LAS f32x2* ropeL = (const LAS f32x2*)(F.lds + 2 * 64 * 144);
    const float* qg = F.q_gain + l * 64; const float* kg = F.k_gain + l * 64;
    const int qtok0 = isctx ? ML + b * CTX + qblk * 128 + qh * 64 : b * SEQ + qblk * 128 + qh * 64;
    const int qpos0 = qblk * 128 + qh * 64;
    bf16x8 Qf[4][2];
#pragma unroll
    for (int qi = 0; qi < 4; ++qi) {
        const int tok = qtok0 + 16 * qi + fr, pos = qpos0 + 16 * qi + fr;
        float v[2][8]; float ss = 0.f;
#pragma unroll
        for (int kk = 0; kk < 2; ++kk) { const u32x4 raw = *(const u32x4*)(F.z + (size_t)tok * ZLD + hq * 64 + 32 * kk + 8 * fq);
#pragma unroll
            for (int e = 0; e < 4; ++e) { v[kk][2 * e] = bf2f(raw[e] & 0xffffu); v[kk][2 * e + 1] = bf2f(raw[e] >> 16); }
#pragma unroll
            for (int i = 0; i < 8; ++i) ss += v[kk][i] * v[kk][i]; }
        ss += __shfl_xor(ss, 16); ss += __shfl_xor(ss, 32);
        const float rstd = rsqrtf(ss * (1.0f / 64.0f) + 1e-6f);
#pragma unroll
        for (int kk = 0; kk < 2; ++kk) {
#pragma unroll
            for (int i = 0; i < 8; ++i) v[kk][i] *= rstd * qg[32 * kk + 8 * fq + i];
            if (!isctx) {
                const int p = kk ? (pos & 63) : (pos >> 6);
                const LAS f32x2* tb = ropeL + p * 16 + 8 * (fq & 1);
#pragma unroll
                for (int i = 0; i < 8; ++i) { const f32x2 cs = tb[i]; const float other = __shfl_xor(v[kk][i], 32);
                    v[kk][i] = (fq & 2) ? v[kk][i] * cs.x + other * cs.y : v[kk][i] * cs.x - other * cs.y; }
            }
            u32x4 w;
#pragma unroll
            for (int e = 0; e < 4; ++e) w[e] = cvt_pk_bf16(v[kk][2 * e] * 0.18033688f, v[kk][2 * e + 1] * 0.18033688f);
            Qf[qi][kk] = __builtin_bit_cast(bf16x8, w);
        }
    }
    float mrow[4], lrow[4];
    f32x4 O[4][4];
    const float snk = F.sink[l * 8 + hq] * 1.44269504f;
#pragma unroll
    for (int qi = 0; qi < 4; ++qi) { mrow[qi] = snk; lrow[qi] = fq == 0 ? 1.0f : 0.0f;
#pragma unroll
        for (int di = 0; di < 4; ++di) O[di][qi] = (f32x4){0.f, 0.f, 0.f, 0.f}; }
    const int jlo = isctx ? 6 : (qblk == 0 ? 2 : 0), jloc_end = isctx ? 6 : (qblk == SEQ / 128 - 1 ? 4 : 6);
    const int kr = tid >> 3, cch = tid & 7;
#define TILE_TOK0(j) ((j) < 6 ? b * SEQ + (qblk - 1) * 128 + (j) * 64 : ML + b * CTX + ((j) - 6) * 64)
#define TILE_NEXT(j) (((j) + 1 == jloc_end && jloc_end < 6) ? 6 : (j) + 1)
    u32x4 kraw, vraw;
    int j = jlo == jloc_end ? 6 : jlo;
    { const size_t tok = (size_t)(TILE_TOK0(j) + kr); kraw = *(const u32x4*)(F.z + tok * ZLD + ZK + hk * 64 + 8 * cch); vraw = *(const u32x4*)(F.z + tok * ZLD + ZV + hk * 64 + 8 * cch); }
    while (j < 10) {
        {
            float v[8]; float ss = 0.f;
#pragma unroll
            for (int e = 0; e < 4; ++e) { v[2 * e] = bf2f(kraw[e] & 0xffffu); v[2 * e + 1] = bf2f(kraw[e] >> 16); }
#pragma unroll
            for (int i = 0; i < 8; ++i) ss += v[i] * v[i];
            ss += __shfl_xor(ss, 1); ss += __shfl_xor(ss, 2); ss += __shfl_xor(ss, 4);
            const float rstd = rsqrtf(ss * (1.0f / 64.0f) + 1e-6f);
#pragma unroll
            for (int i = 0; i < 8; ++i) v[i] *= rstd * kg[8 * cch + i];
            if (j < 6) {
                const int pos = (qblk - 1) * 128 + j * 64 + kr;
                const int p = (cch & 4) ? (pos & 63) : (pos >> 6);
                const LAS f32x2* tb = ropeL + p * 16 + 8 * (cch & 1);
#pragma unroll
                for (int i = 0; i < 8; ++i) { const f32x2 cs = tb[i]; const float other = __shfl_xor(v[i], 2);
                    v[i] = (cch & 2) ? v[i] * cs.x + other * cs.y : v[i] * cs.x - other * cs.y; }
            }
            u32x4 w;
#pragma unroll
            for (int e = 0; e < 4; ++e) w[e] = cvt_pk_bf16(v[2 * e], v[2 * e + 1]);
            *(LAS u32x4*)(Kb + kr * 144 + cch * 16) = w;
#pragma unroll
            for (int e = 0; e < 4; ++e) { Vt[(8 * cch + 2 * e) * 72 + kr] = (bf16_t)(vraw[e] & 0xffffu); Vt[(8 * cch + 2 * e + 1) * 72 + kr] = (bf16_t)(vraw[e] >> 16); }
        }
        __syncthreads();
        const int jn = TILE_NEXT(j);
        if (jn < 10) { const size_t tok = (size_t)(TILE_TOK0(jn) + kr); kraw = *(const u32x4*)(F.z + tok * ZLD + ZK + hk * 64 + 8 * cch); vraw = *(const u32x4*)(F.z + tok * ZLD + ZV + hk * 64 + 8 * cch); }
        const int kpos0 = (qblk - 1) * 128 + j * 64;
        const bool local = j < 6;
        const bool active = !local || (kpos0 + 63 >= qpos0 - 128 && kpos0 <= qpos0 + 63 + 128);
        if (active) {
            const bool need_mask = local && !(kpos0 + 63 - qpos0 <= 128 && qpos0 + 63 - kpos0 <= 128);
#pragma unroll
            for (int kh = 0; kh < 2; ++kh) {
                f32x4 s[2][4];
#pragma unroll
                for (int ki = 0; ki < 2; ++ki) {
                    const bf16x8 k0 = *(const LAS bf16x8*)(Kb + (32 * kh + 16 * ki + fr) * 144 + (8 * fq) * 2);
                    const bf16x8 k1 = *(const LAS bf16x8*)(Kb + (32 * kh + 16 * ki + fr) * 144 + (32 + 8 * fq) * 2);
#pragma unroll
                    for (int qi = 0; qi < 4; ++qi) {
                        f32x4 a = __builtin_amdgcn_mfma_f32_16x16x32_bf16(k0, Qf[qi][0], (f32x4){0.f, 0.f, 0.f, 0.f}, 0, 0, 0);
                        s[ki][qi] = __builtin_amdgcn_mfma_f32_16x16x32_bf16(k1, Qf[qi][1], a, 0, 0, 0);
                    }
                }
                if (need_mask) {
#pragma unroll
                    for (int ki = 0; ki < 2; ++ki)
#pragma unroll
                        for (int qi = 0; qi < 4; ++qi)
#pragma unroll
                            for (int jj = 0; jj < 4; ++jj) { const int dk = (kpos0 + 32 * kh + 16 * ki + 4 * fq + jj) - (qpos0 + 16 * qi + fr);
                                if (dk > 128 || dk < -128) s[ki][qi][jj] = -1e30f; }
                }
                bf16x8 Pf[4];
#pragma unroll
                for (int qi = 0; qi < 4; ++qi) {
                    float mx = -1e30f;
#pragma unroll
                    for (int ki = 0; ki < 2; ++ki)
#pragma unroll
                        for (int jj = 0; jj < 4; ++jj) mx = fmaxf(mx, s[ki][qi][jj]);
                    mx = fmaxf(mx, __shfl_xor(mx, 16)); mx = fmaxf(mx, __shfl_xor(mx, 32));
                    const float mn = fmaxf(mrow[qi], mx), alpha = __builtin_amdgcn_exp2f(mrow[qi] - mn);
                    mrow[qi] = mn;
                    float ps = 0.f;
#pragma unroll
                    for (int ki = 0; ki < 2; ++ki)
#pragma unroll
                        for (int jj = 0; jj < 4; ++jj) { const float p = __builtin_amdgcn_exp2f(s[ki][qi][jj] - mn); s[ki][qi][jj] = p; ps += p; }
                    lrow[qi] = lrow[qi] * alpha + ps;
                    if (__builtin_amdgcn_ballot_w64(alpha != 1.0f) != 0ull) {
#pragma unroll
                        for (int di = 0; di < 4; ++di) O[di][qi] *= alpha; }
                    u32x4 w;
                    w.x = cvt_pk_bf16(s[0][qi][0], s[0][qi][1]); w.y = cvt_pk_bf16(s[0][qi][2], s[0][qi][3]);
                    w.z = cvt_pk_bf16(s[1][qi][0], s[1][qi][1]); w.w = cvt_pk_bf16(s[1][qi][2], s[1][qi][3]);
                    Pf[qi] = __builtin_bit_cast(bf16x8, w);
                }
#pragma unroll
                for (int di = 0; di < 4; ++di) {
                    const LAS bf16_t* vp = Vt + (16 * di + fr) * 72 + 32 * kh + 4 * fq;
                    const u32x2 a = *(const LAS u32x2*)vp, c2 = *(const LAS u32x2*)(vp + 16);
                    u32x4 w; w.x = a.x; w.y = a.y; w.z = c2.x; w.w = c2.y;
                    const bf16x8 vf = __builtin_bit_cast(bf16x8, w);
#pragma unroll
                    for (int qi = 0; qi < 4; ++qi) O[di][qi] = __builtin_amdgcn_mfma_f32_16x16x32_bf16(vf, Pf[qi], O[di][qi], 0, 0, 0);
                }
            }
        }
        __syncthreads();
        j = jn;
    }
#undef TILE_TOK0
#undef TILE_NEXT
#pragma unroll
    for (int qi = 0; qi < 4; ++qi) {
        float lt = lrow[qi]; lt += __shfl_xor(lt, 16); lt += __shfl_xor(lt, 32);
        const float il = 1.0f / lt;
        bf16_t* orow = F.at + (size_t)(qtok0 + 16 * qi + fr) * 512 + hq * 64 + 4 * fq;
#pragma unroll
        for (int di = 0; di < 4; ++di) { const f32x4 o = O[di][qi] * il; u32x2 w; w.x = cvt_pk_bf16(o[0], o[1]); w.y = cvt_pk_bf16(o[2], o[3]); *(u32x2*)(orow + 16 * di) = w; }
    }
}

__device__ void attn_phase(const Frame& F, int l, bool lastl) {
    { LAS f32x2* ropeL = (LAS f32x2*)(F.lds + 2 * 64 * 144); for (int e = opaque_v(F.tid); e < 1024; e += 512) ropeL[e] = F.rope[e]; }
    pooldiff_phase(F, lastl ? ML : MT);
    __syncthreads();
    const int nctx = lastl ? 0 : 32;
    const int vc = (F.G % 8 == 0) ? (F.bid % 8) * (F.G / 8) + F.bid / 8 : F.bid;
    for (int k = (F.bid < nctx) ? -1 : 0; ; ++k) {
        const bool isc = k < 0; const int v = isc ? F.bid : vc + k * F.G;
        if (!isc && v >= 512) break;
        attn_unit(F, l, isc, isc ? (v >> 2) : (v >> 6), isc ? ((v >> 1) & 1) : ((v >> 1) & 31), v & 1);
    }
}

__device__ void fixup_phase(const Frame& F, int l, int ngrp, bf16_t* act) {
    const float* cw = F.conv_w + (size_t)l * 3 * UPW; const float* cb = F.conv_b + (size_t)l * UPW;
    const int tidf = opaque_v(F.tid);
    for (int idx = F.bid * 512 + tidf; idx < ngrp * 2 * 704; idx += F.G * 512) {
        const int c4 = idx % 704, rb = idx / 704, grp = rb >> 1, bot = rb & 1, ch = c4 * 4;
        bool edge;
        if (grp < 256) edge = bot ? ((grp & 31) == 31) : ((grp & 31) == 0); else edge = bot ? (((grp - 256) & 1) == 1) : (((grp - 256) & 1) == 0);
        const float* U = F.ub;
#define UB(g_, s_, h_) (*(const f32x4*)(U + ((size_t)((g_) * 4 + (s_)) * 2 + (h_)) * DFF + ch))
        f32x4 pa, pb, ca, cbv, na, nb; const f32x4 zero = (f32x4){0.f, 0.f, 0.f, 0.f};
        if (!bot) { ca = UB(grp, 0, 0); cbv = UB(grp, 0, 1); na = UB(grp, 1, 0); nb = UB(grp, 1, 1);
            if (edge) { pa = zero; pb = zero; } else { pa = UB(grp - 1, 3, 0); pb = UB(grp - 1, 3, 1); } }
        else { ca = UB(grp, 3, 0); cbv = UB(grp, 3, 1); pa = UB(grp, 2, 0); pb = UB(grp, 2, 1);
            if (edge) { na = zero; nb = zero; } else { na = UB(grp + 1, 0, 0); nb = UB(grp + 1, 0, 1); } }
#undef UB
        const f32x4 ua = *(const f32x4*)(cb + ch) + *(const f32x4*)(cw + ch) * pa + *(const f32x4*)(cw + UPW + ch) * ca + *(const f32x4*)(cw + 2 * UPW + ch) * na;
        const f32x4 uv = *(const f32x4*)(cb + DFF + ch) + *(const f32x4*)(cw + DFF + ch) * pb + *(const f32x4*)(cw + UPW + DFF + ch) * cbv + *(const f32x4*)(cw + 2 * UPW + DFF + ch) * nb;
        float o[4];
#pragma unroll
        for (int j2 = 0; j2 < 4; ++j2) o[j2] = ua[j2] * sigmoidf_(ua[j2]) * uv[j2];
        u32x2 w; w.x = cvt_pk_bf16(o[0], o[1]); w.y = cvt_pk_bf16(o[2], o[3]);
        *(u32x2*)(act + (size_t)(grp * 128 + (bot ? 127 : 0)) * DFF + ch) = w;
    }
}


#define XB_TMO      128
#define XB_XCNT(j)  (256  + 64 * (j))
#define XB_XSUB(j)  (1280 + 64 * (j))
#define XB_XGEN(j)  (2304 + 64 * (j))
#define XB_TOP      3328
#define XB_TOPGEN   3392
#define XCD_BAR_WORDS 3456
#define XB_SPIN_CAP (1u << 18)
__device__ __forceinline__ unsigned xb_ld(unsigned* p)              { return __hip_atomic_load(p, __ATOMIC_RELAXED, __HIP_MEMORY_SCOPE_AGENT); }
__device__ __forceinline__ unsigned xb_add(unsigned* p, unsigned v) { return __hip_atomic_fetch_add(p, v, __ATOMIC_RELAXED, __HIP_MEMORY_SCOPE_AGENT); }
__device__ __forceinline__ unsigned xb_xcc_id() { return (unsigned)__builtin_amdgcn_s_getreg((3 << 11) | 20) & 0xFu; }
#define XB_SPIN(cond, bar) do { unsigned _sp = 0; while (cond) { __builtin_amdgcn_s_sleep(1); \
    if ((++_sp & 255u) == 0u) { if (xb_ld(&(bar)[XB_TMO])) break; if (_sp > XB_SPIN_CAP) { atomicAdd(&(bar)[XB_TMO], 1u); break; } } } } while (0)
struct XcdBarrier { unsigned* bar; unsigned x; volatile LAS unsigned* st; };
__device__ __forceinline__ XcdBarrier xcd_barrier_post(unsigned* bar, volatile LAS unsigned* st) {
    XcdBarrier b; b.bar = bar; b.x = xb_xcc_id(); b.st = st;
    if (threadIdx.x == 0) (void)xb_add(&bar[XB_XCNT(b.x)], 1u);
    return b;
}
__device__ __forceinline__ void xcd_barrier_complete(unsigned* bar, unsigned x, unsigned& nloc, unsigned& nx) {
    const unsigned G = gridDim.x * gridDim.y * gridDim.z;
    unsigned sum, cnt, mine, sp = 0u;
    for (;;) {
        sum = 0u; cnt = 0u; mine = 0u;
#pragma unroll
        for (unsigned j = 0; j < 16; ++j) { const unsigned c = xb_ld(&bar[XB_XCNT(j)]); sum += c; cnt += (c > 0u) ? 1u : 0u; mine = (j == x) ? c : mine; }
        if (sum == G) break;
        __builtin_amdgcn_s_sleep(1);
        if ((++sp & 255u) == 0u) { if (xb_ld(&bar[XB_TMO])) break; if (sp > XB_SPIN_CAP) { atomicAdd(&bar[XB_TMO], 1u); break; } }
    }
    nloc = mine > 0u ? mine : 1u; nx = cnt > 0u ? cnt : 1u;
}
__device__ __forceinline__ void xcd_barrier(const XcdBarrier& b, int wid) {
    asm volatile("s_waitcnt vmcnt(0)" ::: "memory");
    __syncthreads();
    if (fresh_tid(wid) == 0) {
        unsigned* bar = b.bar;
        __builtin_amdgcn_s_waitcnt(0);
        unsigned nloc = b.st[0], nx = b.st[1];
        if (nloc == 0u) { xcd_barrier_complete(bar, b.x, nloc, nx); b.st[0] = nloc; b.st[1] = nx; }
        const unsigned old = xb_add(&bar[XB_XSUB(b.x)], 1u);
        const unsigned gen = old / nloc;
        if (old + 1u == (gen + 1u) * nloc) {
            __builtin_amdgcn_fence(__ATOMIC_RELEASE, "agent");
            asm volatile("s_waitcnt vmcnt(0)" ::: "memory");
            const unsigned og = xb_add(&bar[XB_TOP], 1u);
            const unsigned tg = og / nx;
            if (og + 1u == (tg + 1u) * nx) xb_add(&bar[XB_TOPGEN], 1u);
            else XB_SPIN(xb_ld(&bar[XB_TOPGEN]) == tg, bar);
            __builtin_amdgcn_fence(__ATOMIC_ACQUIRE, "agent");
            xb_add(&bar[XB_XGEN(b.x)], 1u);
            asm volatile("s_waitcnt vmcnt(0)" ::: "memory");
        } else {
            XB_SPIN(xb_ld(&bar[XB_XGEN(b.x)]) == gen, bar);
            __builtin_amdgcn_fence(__ATOMIC_ACQUIRE, "agent");
            asm volatile("s_waitcnt vmcnt(0)" ::: "memory");
        }
    }
    __syncthreads();
}

__device__ __forceinline__ void sched_init(pg8::Sched& S, const Frame& F, int M, int N, int K, const void* A0, const void* B0, const void* A1, const void* B1, int pshift) {
    S.nM = M / 256; S.nN = N / 256; S.nwg = S.nM * S.nN; S.G = F.G; S.c = F.bid; S.pshift = pshift; S.nt = K / 64; S.split = 0;
    S.A0 = (const char*)A0; S.A1 = (const char*)A1; S.B0 = (const char*)B0; S.B1 = (const char*)B1; S.tstepA = (size_t)256 * K * 2; S.tstepB = (size_t)256 * K * 2;
}

__global__ void __launch_bounds__(512, 2) mega(Args a) {
    extern __shared__ __attribute__((aligned(16))) unsigned char shm[];
    volatile LAS unsigned* bst = (volatile LAS unsigned*)((LAS unsigned char*)shm + pg8::STAGE_BYTES);
    const int wid_s = __builtin_amdgcn_readfirstlane((int)(threadIdx.x >> 6));
    if (threadIdx.x == 0) { bst[0] = 0u; bst[1] = 0u; }
    __syncthreads();
    XcdBarrier xbar; xbar.bar = nullptr; xbar.x = 0; xbar.st = bst;
    if (!MULTI_LAUNCH) xbar = xcd_barrier_post((unsigned*)(a.ws + WS_BAR), bst);
    for (int ph = a.ph_lo; ph < a.ph_hi; ++ph) {
        if (ph > a.ph_lo) { if (ph == a.ph_lo + 1) cg::this_grid().sync(); else xcd_barrier(xbar, wid_s); }
        typedef const __attribute__((address_space(4))) Args* KArgsP;
        KArgsP ka = (KArgsP)__builtin_amdgcn_kernarg_segment_ptr();
        asm volatile("" : "+s"(ka));
        Frame F;
        F.x = ka->in[0]; F.c = ka->in[1]; F.ctx = ka->in[2]; F.c_ctx = ka->in[3]; F.w_mod = ka->in[4]; F.b_mod = ka->in[5]; F.norm1_g = ka->in[6]; F.norm2_g = ka->in[7]; F.w_in = ka->in[8];
        F.q_gain = ka->in[9]; F.k_gain = ka->in[10]; F.sink = ka->in[11]; F.w_pool = ka->in[12]; F.pool_scale = ka->in[13]; F.w_br_attn = ka->in[14]; F.w_br_pool = ka->in[15]; F.w_out = ka->in[16];
        F.w_up = ka->in[17]; F.conv_w = ka->in[18]; F.conv_b = ka->in[19]; F.w_down = ka->in[20];
        F.out = ka->out; F.ws = ka->ws;
        F.mod = (float*)(F.ws + WS_MOD); F.rope = (f32x2*)(F.ws + WS_ROPE); F.h = (bf16_t*)(F.ws + WS_H); F.xc = (float*)(F.ws + WS_XC); F.z = (bf16_t*)(F.ws + WS_Z);
        F.at = (bf16_t*)(F.ws + WS_AT); F.pd = (bf16_t*)(F.ws + WS_PD); F.ub = (float*)(F.ws + WS_AT);
        F.lds = (LAS unsigned char*)shm; F.tid = wid_s;     F.G = gridDim.x; F.bid = blockIdx.x;
        bf16_t* const act = F.z;
        bf16_t* const ybuf = F.h;

        if (ph == 0) { if (PHM & 512) prologue(F); continue; }
        const int l = (ph - 1) / PPL, vs = (ph - 1) % PPL, s = (DUPS >= 0 && vs > DUPS) ? vs - 1 : vs; const bool lastl = l == DEPTH - 1;
        const float* xl_in = l == 0 ? F.x : F.out; const float* xc_in = l == 0 ? F.ctx : F.xc;
        const float* modl = F.mod + (size_t)l * 9 * NMOD;
        const unsigned char* wl = F.ws + WS_W + (size_t)l * SZ_WL;
        const int Mg = lastl ? ML : MT;
        pg8::Sched S;
        const int usp = (F.G == 256 && !lastl) ? 1 : 0;
        float* const Pz = (float*)F.z;
        float* const Pt = (float*)(F.ws + WS_Z + (size_t)MT * DFF * 2);
        if (s == 0) norm_phase(F, xl_in, xc_in, F.norm1_g + l * D, modl, 0, D, (l > 0 && F.G == 256) ? Pt : nullptr);
        else if (s == 1) { sched_init(S, F, MT, INW, D, F.h, wl + OFF_WIN, F.h, wl + OFF_WIN, 0); pg8::EpiZ E{F.z}; pg8::gemm_phase<pg8::EpiZ, false>(F.lds, F.tid, D, S, E); }
        else if (s == 2) attn_phase(F, l, lastl);
        else if (s == 3) { sched_init(S, F, Mg, D, 512, F.at, wl + OFF_WA, F.pd, wl + OFF_WE, 1); pg8::EpiMerge E{F.z, ybuf}; pg8::gemm_phase<pg8::EpiMerge, false>(F.lds, F.tid, 512, S, E); }
        else if (s == 4) { sched_init(S, F, usp ? ML : Mg, D, D, ybuf, wl + OFF_WO, ybuf, wl + OFF_WO, 0); S.split = usp;
            pg8::EpiRes E{xl_in, xc_in, F.out, F.xc, modl, Pz, 2 * D}; pg8::gemm_phase<pg8::EpiRes, false>(F.lds, F.tid, D, S, E); }
        else if (s == 5) norm_phase(F, F.out, (usp && l == 0) ? F.ctx : F.xc, F.norm2_g + l * D, modl, 3 * D, 4 * D, usp ? Pz : nullptr);
        else if (s == 6) { sched_init(S, F, Mg, UPW, D, F.h, wl + OFF_WU, F.h, wl + OFF_WU, 0); pg8::EpiUp E{act, F.ub, F.conv_w + (size_t)l * 3 * UPW, F.conv_b + (size_t)l * UPW}; pg8::gemm_phase<pg8::EpiUp, true>(F.lds, F.tid, D, S, E); }
        else if (s == 7) fixup_phase(F, l, Mg / 128, act);
        else { sched_init(S, F, usp ? ML : Mg, D, DFF, act, wl + OFF_WD, act, wl + OFF_WD, 0); S.split = usp;
            pg8::EpiRes E{F.out, F.xc, F.out, F.xc, modl, Pt, 5 * D}; pg8::gemm_phase<pg8::EpiRes, false>(F.lds, F.tid, DFF, S, E); }
    }
}

extern "C" void kernel_launch(void* const* d_in, const int* in_sizes, int n_in, void* d_out, int out_size, void* d_ws, size_t ws_size, hipStream_t stream) {
    constexpr int LDS_BYTES = pg8::STAGE_BYTES + 256;
    static int grid = 0;
    if (grid == 0) {
        if (n_in != 21 || ws_size < WS_TOTAL) { fprintf(stderr, "kernel_launch: unexpected n_in %d / ws %zu (need %zu)\n", n_in, ws_size, (size_t)WS_TOTAL); grid = -1; return; }
        int dev = 0, cus = 0, per_cu = 0;
        hipGetDevice(&dev); hipDeviceGetAttribute(&cus, hipDeviceAttributeMultiprocessorCount, dev);
        if (hipFuncSetAttribute((const void*)mega, hipFuncAttributeMaxDynamicSharedMemorySize, LDS_BYTES) != hipSuccess) { fprintf(stderr, "kernel_launch: hipFuncSetAttribute failed\n"); grid = -1; return; }
        if (hipOccupancyMaxActiveBlocksPerMultiprocessor(&per_cu, (const void*)mega, 512, LDS_BYTES) != hipSuccess || per_cu < 1) { fprintf(stderr, "kernel_launch: occupancy query says %d\n", per_cu); per_cu = 1; }
        (void)hipGetLastError();
        grid = cus * 1;
    }
    if (grid < 0) return;
    Args a{};
    for (int i = 0; i < 21; ++i) a.in[i] = (const float*)d_in[i];
    a.out = (float*)d_out; a.ws = (unsigned char*)d_ws;
#if !MULTI_LAUNCH
    if (hipMemsetAsync((char*)d_ws + WS_BAR, 0, XCD_BAR_WORDS * 4, stream) != hipSuccess) { fprintf(stderr, "kernel_launch: memset failed\n"); return; }
#endif
#if MULTI_LAUNCH
    for (int ph = 0; ph < NPHASE; ++ph) { a.ph_lo = ph; a.ph_hi = ph + 1; hipLaunchKernelGGL(mega, dim3(grid), dim3(512), LDS_BYTES, stream, a); }
#else
    a.ph_lo = 0; a.ph_hi = NPHASE;
    void* args[] = {&a};
    hipError_t e = hipLaunchCooperativeKernel((const void*)mega, dim3(grid), dim3(512), args, LDS_BYTES, stream);
    if (e != hipSuccess) fprintf(stderr, "cooperative launch failed: %s (grid %d)\n", hipGetErrorString(e), grid);
#endif
}
```

```cpp
#include <hip/hip_runtime.h>
#include <hip/hip_cooperative_groups.h>
#include <cstdio>
#include <cstdint>
namespace cg = cooperative_groups;

#ifndef DUPS
#define DUPS -1
#endif
#ifndef PHM
#define PHM 1023
#endif
#ifndef MULTI_LAUNCH
#define MULTI_LAUNCH 0
#endif

#define LAS __attribute__((address_space(3)))
typedef unsigned short bf16_t;
typedef short bf16x8 __attribute__((ext_vector_type(8)));
typedef float f32x4 __attribute__((ext_vector_type(4)));
typedef float f32x2 __attribute__((ext_vector_type(2)));
typedef unsigned u32x4 __attribute__((ext_vector_type(4)));
typedef unsigned u32x2 __attribute__((ext_vector_type(2)));

constexpr int D = 1024, NB = 8, SEQ = 4096, DEPTH = 4, CTX = 256;
constexpr int ML = NB * SEQ, MC = NB * CTX, MT = ML + MC;
constexpr int INW = 3328, DFF = 2816, UPW = 5632;
constexpr int ZLD = 1280;
constexpr size_t GATE_OFF = (size_t)(32768 + 2048) * ZLD * 2;
constexpr int ZK = 512, ZV = 640, ZP = 768, ZGA = 1280, ZGP = 2304;
constexpr int NMOD = 6 * D;
constexpr int PPL = 9 + (DUPS >= 0 ? 1 : 0);
constexpr int NPHASE = 1 + PPL * DEPTH;

constexpr size_t SZ_WIN = (size_t)INW * D * 2, SZ_WA = (size_t)D * 512 * 2, SZ_WE = SZ_WA, SZ_WO = (size_t)D * D * 2, SZ_WU = (size_t)UPW * D * 2, SZ_WD = (size_t)D * DFF * 2;
constexpr size_t OFF_WIN = 0, OFF_WA = OFF_WIN + SZ_WIN, OFF_WE = OFF_WA + SZ_WA, OFF_WO = OFF_WE + SZ_WE, OFF_WU = OFF_WO + SZ_WO, OFF_WD = OFF_WU + SZ_WU, SZ_WL = OFF_WD + SZ_WD;
constexpr size_t WS_W = 0;
constexpr size_t WS_MOD = WS_W + DEPTH * SZ_WL;
constexpr size_t WS_ROPE = WS_MOD + (size_t)DEPTH * 9 * NMOD * 4;
constexpr size_t WS_H = WS_ROPE + 64 * 16 * 8;
constexpr size_t WS_XC = WS_H + (size_t)MT * D * 2;
constexpr size_t WS_Z = WS_XC + (size_t)MC * D * 4;
constexpr size_t WS_AT = WS_Z + (size_t)MT * INW * 2;
constexpr size_t WS_PD = WS_AT + (size_t)MT * 512 * 2;
constexpr size_t WS_END = WS_PD + (size_t)MT * 512 * 2;
constexpr size_t WS_BAR = WS_END;
constexpr size_t WS_TOTAL = WS_BAR + 3456 * 4;
static_assert(WS_TOTAL <= (size_t)512 * 1024 * 1024, "workspace");
static_assert((size_t)272 * 4 * UPW * 4 <= (size_t)MT * 512 * 2, "ub overlay");

struct Args {
    const float* in[21];
    float* out;
    unsigned char* ws;
    int ph_lo, ph_hi;
};

struct Frame {
    const float *x, *c, *ctx, *c_ctx, *w_mod, *b_mod, *norm1_g, *norm2_g, *w_in, *q_gain, *k_gain, *sink, *w_pool, *pool_scale, *w_br_attn, *w_br_pool, *w_out, *w_up, *conv_w, *conv_b, *w_down;
    float* out; unsigned char* ws;
    float* mod; f32x2* rope; bf16_t* h; float* xc; bf16_t* z; bf16_t* at; bf16_t* pd; float* ub;
    LAS unsigned char* lds;
    int tid, G, bid;
};

__device__ __forceinline__ int fresh_tid(int wid) { int lane; asm volatile("v_mbcnt_lo_u32_b32 %0, -1, 0\n\tv_mbcnt_hi_u32_b32 %0, -1, %0" : "=v"(lane)); return wid * 64 + lane; }
__device__ __forceinline__ int opaque_v(int wid) { return fresh_tid(wid); }
__device__ __forceinline__ float bf2f(unsigned v) { return __uint_as_float(v << 16); }
__device__ __forceinline__ bf16_t f2bf(float f) { unsigned u = __float_as_uint(f); u += 0x7FFFu + ((u >> 16) & 1u); return (bf16_t)(u >> 16); }
__device__ __forceinline__ unsigned cvt_pk_bf16(float lo, float hi) { unsigned r; asm volatile("v_cvt_pk_bf16_f32 %0, %1, %2" : "=v"(r) : "v"(lo), "v"(hi)); return r; }
__device__ __forceinline__ float sigmoidf_(float x) { return __builtin_amdgcn_rcpf(1.0f + __expf(-x)); }

namespace pg8 {
constexpr int BM = 256, BK = 64, HALF = 128, HTB = HALF * BK * 2, STAGE_BYTES = 8 * HTB, NXCD = 8, WGM = 8;
__device__ __forceinline__ int lds_byte(int r, int c) { const int st = (r >> 4) * 2 + (c >> 5), rr = r & 15, cc = c & 31, ob = rr * 64 + cc * 2; return st * 1024 + (ob ^ (((ob >> 9) & 1) << 5)); }
__device__ __forceinline__ void stage_rc(int b, int& R, int& C) { const int st = b / 1024, sb = b % 1024, swz = sb ^ (((sb >> 9) & 1) << 5); R = (st >> 1) * 16 + swz / 64; C = (st & 1) * 32 + (swz % 64) / 2; }
__device__ __forceinline__ int perm32(int rho) { const int n = rho >> 4, i = rho & 15; return 8 * (i >> 2) + 4 * n + (i & 3); }

struct Unit { int pm, pn, which, kt0, ntu, ks; };

struct Sched {
    int nM, nN, nwg, G, c, pshift, nt, split;
    const char *A0, *A1, *B0, *B1; size_t tstepA, tstepB;
    __device__ __forceinline__ bool next(int i, Unit& u) const {
        const int ii = i >> pshift; u.which = i & ((1 << pshift) - 1); u.kt0 = 0; u.ntu = nt; u.ks = -1;
        if (split && i == 2) { const int cu = c >> 3, ks = c & 7, pairs = nt >> 1, base = pairs >> 3, rem = pairs & 7;
            u.pm = nM + (cu >> 2); u.pn = cu & 3; u.ks = ks; u.kt0 = 2 * (ks * base + (ks < rem ? ks : rem)); u.ntu = 2 * (base + (ks < rem ? 1 : 0)); return true; }
        const long L = (long)ii * G + c; if (L >= nwg) return false;
        int wgid = (int)L; { const int q = nwg / NXCD, r = nwg % NXCD, xcd = wgid % NXCD, off = wgid / NXCD; wgid = (xcd < r ? xcd * (q + 1) : r * (q + 1) + (xcd - r) * q) + off; }
        const int nig = WGM * nN, gid = wgid / nig, fm = gid * WGM, gsz = (nM - fm) < WGM ? (nM - fm) : WGM;
        u.pm = fm + ((wgid % nig) % gsz); u.pn = (wgid % nig) / gsz; return true;
    }
    __device__ __forceinline__ const char* a_base(const Unit& u) const { return (u.which ? A1 : A0) + (size_t)u.pm * tstepA + (size_t)u.kt0 * 128; }
    __device__ __forceinline__ const char* b_base(const Unit& u) const { return (u.which ? B1 : B0) + (size_t)u.pn * tstepB + (size_t)u.kt0 * 128; }
    __device__ __forceinline__ bool keep(const Unit& u) const { return pshift && u.which == 0; }
};

template <class Epi, bool ROWPERM>
__device__ __forceinline__ void gemm_phase(LAS unsigned char* lds, const int tid_in, const int K, const Sched& S, const Epi& E) {
    const int tid = opaque_v(tid_in);
    const int wid = __builtin_amdgcn_readfirstlane(tid >> 6), lane = tid & 63, wr = wid >> 2, wc = wid & 3, fr = lane & 15, fq = lane >> 4;
    unsigned voffA[2], voffB[2];
#pragma unroll
    for (int i = 0; i < 2; ++i) { int R, C; stage_rc(tid * 16 + i * 8192, R, C); const int Rb = Epi::PERM ? ((R & ~31) + perm32(R & 31)) : R;
        const int Ra = ROWPERM ? (128 * (R >> 6) + 8 * (R & 15) + ((R >> 4) & 3)) : R;
        voffA[i] = (unsigned)(Ra * K + C) * 2u; voffB[i] = (unsigned)(Rb * K + C) * 2u; }
    const size_t kstep = (size_t)(BK * 2);
    const size_t hstepB = (size_t)HALF * K * 2;
    const size_t hstepA = ROWPERM ? (size_t)4 * K * 2 : hstepB;
    const unsigned ldsw = (unsigned)wid * 1024u;
    const int aoff = lds_byte(wr * 64 + fr, fq * 8), boff = lds_byte(wc * 32 + fr, fq * 8);
#define PG8_SA(b, h) (((b) * 2 + (h)) * HTB)
#define PG8_SB(b, h) ((4 + (b) * 2 + (h)) * HTB)
#define PG8_STAGE(bufoff, gbase, voff) do { _Pragma("unroll") for (int _i = 0; _i < 2; ++_i) \
        __builtin_amdgcn_global_load_lds((const unsigned*)((const char*)(gbase) + (voff)[_i]), (LAS unsigned*)(lds + (bufoff) + ldsw + _i * 8192), 16, 0, 0); } while (0)
#define PG8_LDA(dst, b, h) do { _Pragma("unroll") for (int m = 0; m < 4; ++m) _Pragma("unroll") for (int k = 0; k < 2; ++k) dst[m][k] = *(const LAS bf16x8*)(lds + PG8_SA(b, h) + aoff + m * 2048 + k * 1024); } while (0)
#define PG8_LDB(dst, b, h) do { _Pragma("unroll") for (int n = 0; n < 2; ++n) _Pragma("unroll") for (int k = 0; k < 2; ++k) dst[n][k] = *(const LAS bf16x8*)(lds + PG8_SB(b, h) + boff + n * 2048 + k * 1024); } while (0)
#define PG8_MMA(ai, bj, At, Bt) do { __builtin_amdgcn_s_setprio(1); _Pragma("unroll") for (int m = 0; m < 4; ++m) _Pragma("unroll") for (int n = 0; n < 2; ++n) _Pragma("unroll") for (int k = 0; k < 2; ++k) \
        acc[ai][bj][m][n] = __builtin_amdgcn_mfma_f32_16x16x32_bf16(Bt[n][k], At[m][k], acc[ai][bj][m][n], 0, 0, 0); __builtin_amdgcn_s_setprio(0); } while (0)
#define PG8_WAIT_V(n) asm volatile("s_waitcnt vmcnt(" #n ")" ::: "memory")
#define PG8_WAIT_L(n) asm volatile("s_waitcnt lgkmcnt(" #n ")" ::: "memory")
#define PG8_BAR __builtin_amdgcn_s_barrier()
#define PG8_SCHED __builtin_amdgcn_sched_barrier(0)
    Unit cur, nxt; int ui = 0;
    if (!S.next(0, cur)) return;
    f32x4 acc[2][2][4][2];
#pragma unroll
    for (int a = 0; a < 2; ++a)
#pragma unroll
        for (int b = 0; b < 2; ++b)
#pragma unroll
            for (int m = 0; m < 4; ++m)
#pragma unroll
                for (int n = 0; n < 2; ++n) acc[a][b][m][n] = (f32x4){0.f, 0.f, 0.f, 0.f};
    bf16x8 At[4][2], B0[2][2], B1[2][2];
    const char* cA = S.a_base(cur); const char* cB = S.b_base(cur);
    PG8_STAGE(PG8_SB(0, 0), cB, voffB); PG8_STAGE(PG8_SA(0, 0), cA, voffA); PG8_STAGE(PG8_SB(0, 1), cB + hstepB, voffB); PG8_STAGE(PG8_SA(0, 1), cA + hstepA, voffA);
    if (wr == 1) PG8_BAR;
    PG8_WAIT_V(4); PG8_BAR;
    PG8_STAGE(PG8_SB(1, 0), cB + kstep, voffB); PG8_STAGE(PG8_SA(1, 0), cA + kstep, voffA); PG8_STAGE(PG8_SB(1, 1), cB + hstepB + kstep, voffB);
    PG8_WAIT_V(6); PG8_BAR;
    for (;;) {
        const bool has_next = S.next(ui + 1, nxt);
        const char* nA = has_next ? S.a_base(nxt) : cA; const char* nB = has_next ? S.b_base(nxt) : cB;
        const int ntc = cur.ntu;
        for (int t = 0; t < ntc; t += 2) {
            const bool last = (t == ntc - 2);
            const char* a1 = cA + (size_t)(t + 1) * kstep;
            const char* a2 = last ? nA : cA + (size_t)(t + 2) * kstep; const char* b2 = last ? nB : cB + (size_t)(t + 2) * kstep;
            const char* a3 = a2 + kstep; const char* b3 = b2 + kstep;
            PG8_LDB(B0, 0, 0); PG8_SCHED; PG8_LDA(At, 0, 0); PG8_STAGE(PG8_SA(1, 1), a1 + hstepA, voffA);
            PG8_WAIT_L(8); PG8_BAR; PG8_WAIT_L(0); PG8_MMA(0, 0, At, B0); PG8_BAR; PG8_SCHED;
            PG8_LDB(B1, 0, 1); PG8_STAGE(PG8_SB(0, 0), b2, voffB);
            PG8_BAR; PG8_WAIT_L(0); PG8_MMA(0, 1, At, B1); PG8_BAR;
            PG8_LDA(At, 0, 1); PG8_STAGE(PG8_SA(0, 0), a2, voffA);
            PG8_BAR; PG8_WAIT_L(0); PG8_MMA(1, 0, At, B0); PG8_BAR; PG8_SCHED;
            PG8_STAGE(PG8_SB(0, 1), b2 + hstepB, voffB);
            PG8_WAIT_V(6); PG8_BAR; PG8_MMA(1, 1, At, B1); PG8_BAR;
            PG8_LDB(B0, 1, 0); PG8_SCHED; PG8_LDA(At, 1, 0); PG8_STAGE(PG8_SA(0, 1), a2 + hstepA, voffA);
            PG8_WAIT_L(8); PG8_BAR; PG8_WAIT_L(0); PG8_MMA(0, 0, At, B0); PG8_BAR; PG8_SCHED;
            PG8_LDB(B1, 1, 1); PG8_STAGE(PG8_SB(1, 0), b3, voffB);
            PG8_BAR; PG8_WAIT_L(0); PG8_MMA(0, 1, At, B1); PG8_BAR;
            PG8_LDA(At, 1, 1); PG8_STAGE(PG8_SA(1, 0), a3, voffA);
            PG8_BAR; PG8_WAIT_L(0); PG8_MMA(1, 0, At, B0); PG8_BAR; PG8_SCHED;
            PG8_STAGE(PG8_SB(1, 1), b3 + hstepB, voffB);
            PG8_WAIT_V(6); PG8_BAR; PG8_MMA(1, 1, At, B1); PG8_BAR;
        }
        E(acc, cur, wr, wc, fr, fq);
        if (!has_next) break;
        if (!S.keep(cur)) {
#pragma unroll
            for (int a = 0; a < 2; ++a)
#pragma unroll
                for (int b = 0; b < 2; ++b)
#pragma unroll
                    for (int m = 0; m < 4; ++m)
#pragma unroll
                        for (int n = 0; n < 2; ++n) acc[a][b][m][n] = (f32x4){0.f, 0.f, 0.f, 0.f};
        }
        cur = nxt; cA = nA; cB = nB; ++ui;
    }
    PG8_WAIT_V(0);
    if (wr == 0) PG8_BAR;
    PG8_BAR;
#undef PG8_SA
#undef PG8_SB
#undef PG8_STAGE
#undef PG8_LDA
#undef PG8_LDB
#undef PG8_MMA
#undef PG8_WAIT_V
#undef PG8_WAIT_L
#undef PG8_BAR
#undef PG8_SCHED
}

struct EpiZ {
    static constexpr bool PERM = true;
    bf16_t* O;
    __device__ __forceinline__ void operator()(f32x4 (&acc)[2][2][4][2], const Unit& u, int wr, int wc, int fr_, int fq_) const {
        (void)fr_; (void)fq_; const int lane_e = fresh_tid(0); const int fr = lane_e & 15, fq = lane_e >> 4;
        const int row0 = u.pm * BM + wr * 64 + fr, col0 = u.pn * BM + wc * 32 + 8 * fq;
        if (u.pn >= 5) {
            const int gt = (u.pn - 5) >> 2, pq = (u.pn - 5) & 3;
            unsigned char* gb = (unsigned char*)O + GATE_OFF + ((size_t)((gt * 136 + u.pm) * 4 + pq) * 16 * 8 + (wr * 4 + wc)) * 1024 + lane_e * 16;
#pragma unroll
            for (int ai = 0; ai < 2; ++ai)
#pragma unroll
                for (int m = 0; m < 4; ++m)
#pragma unroll
                    for (int bj = 0; bj < 2; ++bj) { const f32x4 v0 = acc[ai][bj][m][0], v1 = acc[ai][bj][m][1];
                        u32x4 w; w.x = cvt_pk_bf16(v0[0], v0[1]); w.y = cvt_pk_bf16(v0[2], v0[3]); w.z = cvt_pk_bf16(v1[0], v1[1]); w.w = cvt_pk_bf16(v1[2], v1[3]);
                        *(u32x4*)(gb + (size_t)((ai * 4 + m) * 2 + bj) * 8 * 1024) = w; }
            return;
        }
#pragma unroll
        for (int ai = 0; ai < 2; ++ai)
#pragma unroll
            for (int m = 0; m < 4; ++m) { bf16_t* rowp = O + (size_t)(row0 + ai * HALF + m * 16) * ZLD + col0;
#pragma unroll
                for (int bj = 0; bj < 2; ++bj) { const f32x4 v0 = acc[ai][bj][m][0], v1 = acc[ai][bj][m][1];
                    u32x4 w; w.x = cvt_pk_bf16(v0[0], v0[1]); w.y = cvt_pk_bf16(v0[2], v0[3]); w.z = cvt_pk_bf16(v1[0], v1[1]); w.w = cvt_pk_bf16(v1[2], v1[3]);
                    *(u32x4*)(rowp + bj * HALF) = w; } }
    }
};

struct EpiMerge {
    static constexpr bool PERM = true;
    const bf16_t* z; bf16_t* y;
    __device__ __forceinline__ void operator()(f32x4 (&acc)[2][2][4][2], const Unit& u, int wr, int wc, int fr_, int fq_) const {
        (void)fr_; (void)fq_; const int lane_e = fresh_tid(0); const int fr = lane_e & 15, fq = lane_e >> 4;
        const int row0 = u.pm * BM + wr * 64 + fr, col0 = u.pn * BM + wc * 32 + 8 * fq;
        const unsigned char* gb = (const unsigned char*)z + GATE_OFF + ((size_t)(u.pm * 4 + u.pn) * 16 * 8 + (wr * 4 + wc)) * 1024 + (fq * 16 + fr) * 16;
#pragma unroll
        for (int ai = 0; ai < 2; ++ai) {
            u32x4 gpv[4][2], gav[4][2];
#pragma unroll
            for (int m = 0; m < 4; ++m)
#pragma unroll
                for (int bj = 0; bj < 2; ++bj) gpv[m][bj] = *(const u32x4*)(gb + (size_t)(136 * 4 * 16 * 8) * 1024 + (size_t)((ai * 4 + m) * 2 + bj) * 8 * 1024);
            if (u.which == 0) {
#pragma unroll
                for (int m = 0; m < 4; ++m)
#pragma unroll
                    for (int bj = 0; bj < 2; ++bj) gav[m][bj] = *(const u32x4*)(gb + (size_t)((ai * 4 + m) * 2 + bj) * 8 * 1024);
            }
#pragma unroll
            for (int m = 0; m < 4; ++m) { const size_t row = (size_t)(row0 + ai * HALF + m * 16);
#pragma unroll
                for (int bj = 0; bj < 2; ++bj) { const int col = col0 + bj * HALF;
                    const u32x4 gp = gpv[m][bj];
                    float ep[8];
#pragma unroll
                    for (int e = 0; e < 4; ++e) { const float lo = bf2f(gp[e] & 0xffffu), hi = bf2f(gp[e] >> 16);
                        ep[2 * e] = __builtin_amdgcn_exp2f(__builtin_amdgcn_fmed3f(lo * -1.44269504f, -43.f, 43.f)); ep[2 * e + 1] = __builtin_amdgcn_exp2f(__builtin_amdgcn_fmed3f(hi * -1.44269504f, -43.f, 43.f)); }
                    if (u.which == 0) {
                        const u32x4 ga = gav[m][bj];
#pragma unroll
                        for (int e = 0; e < 4; ++e) { const float lo = bf2f(ga[e] & 0xffffu), hi = bf2f(ga[e] >> 16);
                            const float ea0 = __builtin_amdgcn_exp2f(__builtin_amdgcn_fmed3f(lo * -1.44269504f, -43.f, 43.f)), ea1 = __builtin_amdgcn_exp2f(__builtin_amdgcn_fmed3f(hi * -1.44269504f, -43.f, 43.f));
                            const float r0 = (1.0f + ep[2 * e]) * __builtin_amdgcn_rcpf(1.0f + ea0), r1 = (1.0f + ep[2 * e + 1]) * __builtin_amdgcn_rcpf(1.0f + ea1);
                            acc[ai][bj][m][e >> 1][(2 * e) & 3] *= r0; acc[ai][bj][m][e >> 1][(2 * e + 1) & 3] *= r1; }
                    } else {
                        float o[8];
#pragma unroll
                        for (int e = 0; e < 8; ++e) o[e] = acc[ai][bj][m][e >> 2][e & 3] * __builtin_amdgcn_rcpf(1.0f + ep[e]);
                        u32x4 w; w.x = cvt_pk_bf16(o[0], o[1]); w.y = cvt_pk_bf16(o[2], o[3]); w.z = cvt_pk_bf16(o[4], o[5]); w.w = cvt_pk_bf16(o[6], o[7]);
                        *(u32x4*)(y + row * D + col) = w;
                    } } }
            asm volatile("" ::: "memory");
        }
    }
};

struct EpiRes {
    static constexpr bool PERM = false;
    const float *xl_in, *xc_in; float *xl_out, *xc_out; const float* modl; float* P; int goff;
    __device__ __forceinline__ void operator()(f32x4 (&acc)[2][2][4][2], const Unit& u, int wr, int wc, int fr_, int fq_) const {
        (void)fr_; (void)fq_; const int lane_e = fresh_tid(0); const int fr = lane_e & 15, fq = lane_e >> 4;
        const bool lat = u.pm < ML / BM;
        const int rbase = (lat ? u.pm * BM : u.pm * BM - ML) + wr * 64 + fr;
        const float* xin = lat ? xl_in : xc_in; float* xout = lat ? xl_out : xc_out;
        const float* gv = modl + (size_t)(lat ? (u.pm >> 4) : 8) * NMOD + goff;
        const int col0 = u.pn * BM + wc * 32 + 4 * fq;
        f32x4 g[2][2];
#pragma unroll
        for (int bj = 0; bj < 2; ++bj)
#pragma unroll
            for (int n = 0; n < 2; ++n) g[bj][n] = *(const f32x4*)(gv + col0 + bj * HALF + n * 16);
        if (u.ks >= 0) {
            float* pp = P + ((size_t)u.ks * MC + rbase) * D + col0;
#pragma unroll
            for (int ai = 0; ai < 2; ++ai)
#pragma unroll
                for (int m = 0; m < 4; ++m)
#pragma unroll
                    for (int bj = 0; bj < 2; ++bj)
#pragma unroll
                        for (int n = 0; n < 2; ++n) *(f32x4*)(pp + (size_t)(ai * HALF + m * 16) * D + bj * HALF + n * 16) = g[bj][n] * acc[ai][bj][m][n];
            return;
        }
#pragma unroll
        for (int ai = 0; ai < 2; ++ai) {
            f32x4 xi[4][2][2];
#pragma unroll
            for (int m = 0; m < 4; ++m) { const size_t off = (size_t)(rbase + ai * HALF + m * 16) * D + col0;
#pragma unroll
                for (int bj = 0; bj < 2; ++bj)
#pragma unroll
                    for (int n = 0; n < 2; ++n) xi[m][bj][n] = *(const f32x4*)(xin + off + bj * HALF + n * 16); }
#pragma unroll
            for (int m = 0; m < 4; ++m) { const size_t off = (size_t)(rbase + ai * HALF + m * 16) * D + col0;
#pragma unroll
                for (int bj = 0; bj < 2; ++bj)
#pragma unroll
                    for (int n = 0; n < 2; ++n) *(f32x4*)(xout + off + bj * HALF + n * 16) = xi[m][bj][n] + g[bj][n] * acc[ai][bj][m][n]; }
            asm volatile("" ::: "memory");
        }
    }
};

struct EpiUp {
    static constexpr bool PERM = true;
    bf16_t* act; float* ub; const float* cw; const float* cb;
    __device__ __forceinline__ void operator()(f32x4 (&acc)[2][2][4][2], const Unit& u, int wr, int wc, int fr_, int fq_) const {
        (void)fr_; (void)fq_; const int lane_e = fresh_tid(0); const int fr = lane_e & 15, fq = lane_e >> 4;
        const int lane = fq * 16 + fr;
        const int srcU = (lane & 48) | ((fr + 15) & 15), srcD = (lane & 48) | ((fr + 1) & 15);
        const int grp = 2 * u.pm + wr;
        const size_t tok0 = (size_t)grp * 128;
        if (fr == 0) {
#pragma unroll
            for (int n = 0; n < 2; ++n) { float* p = ub + ((size_t)(grp * 4) * 2) * DFF + 128 * u.pn + 32 * wc + 8 * fq + 4 * n;
                *(f32x4*)p = acc[0][0][0][n]; *(f32x4*)(p + DFF) = acc[0][1][0][n]; *(f32x4*)(p + 2 * DFF) = acc[0][0][1][n]; *(f32x4*)(p + 3 * DFF) = acc[0][1][1][n]; }
        }
        if (fr == 15) {
#pragma unroll
            for (int n = 0; n < 2; ++n) { float* p = ub + ((size_t)(grp * 4 + 2) * 2) * DFF + 128 * u.pn + 32 * wc + 8 * fq + 4 * n;
                *(f32x4*)p = acc[1][0][2][n]; *(f32x4*)(p + DFF) = acc[1][1][2][n]; *(f32x4*)(p + 2 * DFF) = acc[1][0][3][n]; *(f32x4*)(p + 3 * DFF) = acc[1][1][3][n]; }
        }
        u32x2 keep[8];
#pragma unroll
        for (int n = 0; n < 2; ++n) {
            const int ch = 128 * u.pn + 32 * wc + 8 * fq + 4 * n;
            const f32x4 w0a = *(const f32x4*)(cw + ch), w1a = *(const f32x4*)(cw + UPW + ch), w2a = *(const f32x4*)(cw + 2 * UPW + ch), cba = *(const f32x4*)(cb + ch);
            const f32x4 w0b = *(const f32x4*)(cw + DFF + ch), w1b = *(const f32x4*)(cw + UPW + DFF + ch), w2b = *(const f32x4*)(cw + 2 * UPW + DFF + ch), cbb = *(const f32x4*)(cb + DFF + ch);
            f32x4 hua, hub, hda, hdb;
            { const f32x4 la = acc[1][0][3][n], lb = acc[1][1][3][n], fa = acc[0][0][0][n], fb = acc[0][1][0][n];
#pragma unroll
              for (int j = 0; j < 4; ++j) { hua[j] = __shfl(la[j], srcU); hub[j] = __shfl(lb[j], srcU); hda[j] = __shfl(fa[j], srcD); hdb[j] = __shfl(fb[j], srcD); } }
#pragma unroll
            for (int q = 0; q < 8; ++q) {
                const int ai = q >> 2, m = q & 3;
                const f32x4 ca = acc[ai][0][m][n], cbv = acc[ai][1][m][n];
                const f32x4 upa = q > 0 ? acc[(q - 1) >> 2][0][(q - 1) & 3][n] : hua, upb = q > 0 ? acc[(q - 1) >> 2][1][(q - 1) & 3][n] : hub;
                const f32x4 dna = q < 7 ? acc[(q + 1) >> 2][0][(q + 1) & 3][n] : hda, dnb = q < 7 ? acc[(q + 1) >> 2][1][(q + 1) & 3][n] : hdb;
                const f32x4 ua = cba + w0a * upa + w1a * ca + w2a * dna, uv = cbb + w0b * upb + w1b * cbv + w2b * dnb;
                const int g = 8 * fr + q;
                float o[4];
#pragma unroll
                for (int j = 0; j < 4; ++j) o[j] = ua[j] * sigmoidf_(ua[j]) * uv[j];
                u32x2 w; w.x = cvt_pk_bf16(o[0], o[1]); w.y = cvt_pk_bf16(o[2], o[3]);
                if (n == 0) keep[q] = w;
                else if (g != 0 && g != 127) { u32x4 ww; ww.x = keep[q].x; ww.y = keep[q].y; ww.z = w.x; ww.w = w.y; *(u32x4*)(act + (tok0 + g) * DFF + ch - 4) = ww; }
            }
        }
    }
};
}

__device__ __forceinline__ void transpose_tile(const Frame& F, const float* src, int K, int N, bf16_t* dst, int k0, int n0, bool upperm) {
    LAS bf16_t* T = (LAS bf16_t*)F.lds;
    const int t = opaque_v(F.tid);
    { const int kk = t >> 3, nc = (t & 7) * 8;
      const float* p = src + (size_t)(k0 + kk) * N + n0 + nc;
      f32x4 a[4], b[4];
#pragma unroll
      for (int sb = 0; sb < 4; ++sb) { a[sb] = *(const f32x4*)(p + sb * 64); b[sb] = *(const f32x4*)(p + sb * 64 + 4); }
#pragma unroll
      for (int sb = 0; sb < 4; ++sb)
#pragma unroll
        for (int i = 0; i < 4; ++i) { T[(sb * 64 + nc + i) * 66 + kk] = f2bf(a[sb][i]); T[(sb * 64 + nc + 4 + i) * 66 + kk] = f2bf(b[sb][i]); } }
    __syncthreads();
#pragma unroll
    for (int sb = 0; sb < 4; ++sb) { const int nn = sb * 64 + (t >> 3), kc = (t & 7) * 8;
      const LAS unsigned* q = (const LAS unsigned*)(T + nn * 66 + kc);
      u32x4 w; w.x = q[0]; w.y = q[1]; w.z = q[2]; w.w = q[3];
      int n = n0 + nn;
      if (upperm) { const int half = n / DFF, chn = n % DFF; n = 256 * (chn >> 7) + 128 * half + (chn & 127); }
      *(u32x4*)(dst + (size_t)n * K + k0 + kc) = w; }
    __syncthreads();
}

__device__ void prologue(const Frame& F) {
    const int t = opaque_v(F.tid);
    constexpr int T_IN = 16 * 13, T_A = 8 * 4, T_O = 16 * 4, T_U = 16 * 22, T_D = 44 * 4, T_L = T_IN + T_A + T_O + T_U + T_D;
    for (int T = F.bid; T < DEPTH * T_L; T += F.G) {
        const int l = T / T_L; int r = T % T_L;
        unsigned char* wl = F.ws + WS_W + (size_t)l * SZ_WL;
        if (r < T_IN) { transpose_tile(F, F.w_in + (size_t)l * D * INW, D, INW, (bf16_t*)(wl + OFF_WIN), (r / 13) * 64, (r % 13) * 256, false); continue; } r -= T_IN;
        if (r < T_A) { transpose_tile(F, F.w_br_attn + (size_t)l * 512 * D, 512, D, (bf16_t*)(wl + OFF_WA), (r / 4) * 64, (r % 4) * 256, false); continue; } r -= T_A;
        if (r < T_O) { transpose_tile(F, F.w_out + (size_t)l * D * D, D, D, (bf16_t*)(wl + OFF_WO), (r / 4) * 64, (r % 4) * 256, false); continue; } r -= T_O;
        if (r < T_U) { transpose_tile(F, F.w_up + (size_t)l * D * UPW, D, UPW, (bf16_t*)(wl + OFF_WU), (r / 22) * 64, (r % 22) * 256, true); continue; } r -= T_U;
        transpose_tile(F, F.w_down + (size_t)l * DFF * D, DFF, D, (bf16_t*)(wl + OFF_WD), (r / 4) * 64, (r % 4) * 256, false);
    }
    for (int it = F.bid; it < DEPTH * 256; it += F.G) {
        const int idx = it * 512 + t, n = (idx & 255) * 4, gc = (idx >> 8) & 511, l = idx >> 17, g = gc >> 7;
        const float* wp = F.w_pool + ((size_t)l * 512 + gc) * 128;
        const float* ps = F.pool_scale + (size_t)l * 512 + g * 128;
        const float* wb = F.w_br_pool + ((size_t)l * 512 + g * 128) * D + n;
        f32x4 s4 = (f32x4){0.f, 0.f, 0.f, 0.f};
#pragma unroll 8
        for (int d = 0; d < 128; ++d) s4 += (wp[d] * ps[d]) * *(const f32x4*)(wb + (size_t)d * D);
        bf16_t* o = (bf16_t*)(F.ws + WS_W + (size_t)l * SZ_WL + OFF_WE) + (size_t)n * 512 + gc;
        o[0] = f2bf(s4[0]); o[512] = f2bf(s4[1]); o[1024] = f2bf(s4[2]); o[1536] = f2bf(s4[3]);
    }
    {
        LAS float* sc = (LAS float*)F.lds;
        LAS float* red = sc + 9 * 1024;
        for (int it = F.bid; it < DEPTH * 64; it += F.G) {
            const int l = it >> 6, n0 = (it & 63) * 96;
            __syncthreads();
            for (int e = t; e < 9 * 1024; e += 512) { const int i = e >> 10, k = e & 1023; const float v = i < 8 ? F.c[i * D + k] : F.c_ctx[k]; sc[e] = v * sigmoidf_(v); }
            __syncthreads();
            if (t < 384) {
                const int col = t % 96, kg = t / 96;
                const float* w = F.w_mod + (size_t)l * D * NMOD + (size_t)(kg * 256) * NMOD + n0 + col;
                float a0 = 0, a1 = 0, a2 = 0, a3 = 0, a4 = 0, a5 = 0, a6 = 0, a7 = 0, a8 = 0;
#pragma unroll 8
                for (int k = 0; k < 256; ++k) { const float wv = w[(size_t)k * NMOD]; const LAS float* s = sc + kg * 256 + k;
                    a0 += s[0] * wv; a1 += s[1024] * wv; a2 += s[2048] * wv; a3 += s[3072] * wv; a4 += s[4096] * wv; a5 += s[5120] * wv; a6 += s[6144] * wv; a7 += s[7168] * wv; a8 += s[8192] * wv; }
                LAS float* r = red + kg * 9 * 96 + col;
                r[0] = a0; r[96] = a1; r[192] = a2; r[288] = a3; r[384] = a4; r[480] = a5; r[576] = a6; r[672] = a7; r[768] = a8;
            }
            __syncthreads();
            for (int e = t; e < 9 * 96; e += 512) { const int i = e / 96, col = e % 96;
                const float v = red[e] + red[864 + e] + red[1728 + e] + red[2592 + e] + F.b_mod[(size_t)l * NMOD + n0 + col];
                F.mod[((size_t)l * 9 + i) * NMOD + n0 + col] = v; }
        }
        __syncthreads();
    }
    if (F.bid == (F.G > 1 ? 1 : 0)) {
        for (int e = t; e < 1024; e += 512) {
            const int pos = e >> 4, f = e & 15;
            double inv = 1.0; for (int i = 0; i < f; ++i) inv *= 0.56234132519034908;
            double cs = 1.0, sn = inv, term_c = 1.0, term_s = inv; const double x2 = inv * inv;
            for (int k = 1; k < 14; ++k) { term_c *= -x2 / (double)((2 * k - 1) * (2 * k)); term_s *= -x2 / (double)((2 * k) * (2 * k + 1)); cs += term_c; sn += term_s; }
            double cr = 1.0, sr = 0.0;
            for (int i = 0; i < pos; ++i) { const double c2 = cr * cs - sr * sn, s2 = sr * cs + cr * sn; cr = c2; sr = s2; }
            F.rope[e] = (f32x2){(float)cr, (float)sr};
        }
    }
}

__device__ void norm_phase(const Frame& F, const float* xl, const float* xc, const float* gvec, const float* modl, int shoff, int scoff, const float* P) {
    const int tidn = opaque_v(F.tid); const int lane = tidn & 63, wv = tidn >> 6;
    const int stride = F.G * 8;
    int row = F.bid * 8 + wv;
    f32x4 nx[4], nsc[4], nsh[4];
    if (row < MT) { const float* src = row < ML ? xl + (size_t)row * D : xc + (size_t)(row - ML) * D; const float* mv0 = modl + (size_t)(row < ML ? (row >> 12) : 8) * NMOD;
#pragma unroll
        for (int j = 0; j < 4; ++j) { nx[j] = *(const f32x4*)(src + j * 256 + lane * 4); nsc[j] = *(const f32x4*)(mv0 + scoff + j * 256 + lane * 4); nsh[j] = *(const f32x4*)(mv0 + shoff + j * 256 + lane * 4); } }
    while (row < MT) {
        const bool lat = row < ML;
        const float* mv = modl + (size_t)(lat ? (row >> 12) : 8) * NMOD;
        f32x4 v[4], g[4], sc[4], sh[4];
#pragma unroll
        for (int j = 0; j < 4; ++j) { v[j] = nx[j]; sc[j] = nsc[j]; sh[j] = nsh[j]; }
        const int rown = row + stride;
        if (rown < MT) { const float* src = rown < ML ? xl + (size_t)rown * D : xc + (size_t)(rown - ML) * D; const float* mvn = modl + (size_t)(rown < ML ? (rown >> 12) : 8) * NMOD;
#pragma unroll
            for (int j = 0; j < 4; ++j) { nx[j] = *(const f32x4*)(src + j * 256 + lane * 4); nsc[j] = *(const f32x4*)(mvn + scoff + j * 256 + lane * 4); nsh[j] = *(const f32x4*)(mvn + shoff + j * 256 + lane * 4); } }
#pragma unroll
        for (int j = 0; j < 4; ++j) { const int col = j * 256 + lane * 4; g[j] = *(const f32x4*)(gvec + col); }
        if (P && !lat) {
#pragma unroll
            for (int j = 0; j < 4; ++j) { const float* pr = P + (size_t)(row - ML) * D + j * 256 + lane * 4;
#pragma unroll
                for (int k = 0; k < 8; ++k) v[j] += *(const f32x4*)(pr + (size_t)k * MC * D);
                *(f32x4*)(F.xc + (size_t)(row - ML) * D + j * 256 + lane * 4) = v[j]; }
        }
        float ss = 0.f;
#pragma unroll
        for (int j = 0; j < 4; ++j) ss += v[j][0] * v[j][0] + v[j][1] * v[j][1] + v[j][2] * v[j][2] + v[j][3] * v[j][3];
#pragma unroll
        for (int o = 32; o >= 1; o >>= 1) ss += __shfl_xor(ss, o);
        const float rstd = rsqrtf(ss * (1.0f / D) + 1e-6f);
#pragma unroll
        for (int j = 0; j < 4; ++j) { const int col = j * 256 + lane * 4;
            const f32x4 y = v[j] * rstd * g[j] * (1.0f + sc[j]) + sh[j];
            u32x2 w; w.x = cvt_pk_bf16(y[0], y[1]); w.y = cvt_pk_bf16(y[2], y[3]);
            *(u32x2*)(F.h + (size_t)row * D + col) = w; }
        row = rown;
    }
}

template <int W2>
__device__ __forceinline__ void pooldiff_item(const Frame& F, int tok0, int col) {
    int s0, len;
    if (tok0 < ML) { s0 = tok0 & ~(SEQ - 1); len = SEQ; } else { s0 = ML + ((tok0 - ML) & ~(CTX - 1)); len = CTX; }
    const int tt0 = tok0 - s0;
    constexpr int NR = 8 + 2 * W2;
    u32x4 v[NR];
#pragma unroll
    for (int r = 0; r < NR; ++r) { int rr = tt0 - W2 + r; rr = rr < 0 ? 0 : (rr >= len ? len - 1 : rr); v[r] = *(const u32x4*)(F.z + (size_t)(s0 + rr) * ZLD + ZP + col); }
#pragma unroll
    for (int i = 0; i < 8; ++i) {
        float s[8];
#pragma unroll
        for (int e = 0; e < 8; ++e) s[e] = 0.f;
#pragma unroll
        for (int r = i; r < i + 2 * W2; ++r) { const int rr = tt0 - W2 + r; const float wgt = (rr >= 0 && rr < len) ? 1.0f : 0.0f;
#pragma unroll
            for (int e = 0; e < 4; ++e) { s[2 * e] += wgt * bf2f(v[r][e] & 0xffffu); s[2 * e + 1] += wgt * bf2f(v[r][e] >> 16); } }
        const int tt = tt0 + i, lo = max(tt - W2, 0), hi = min(tt + W2, len);
        const float inv = 1.0f / (float)(hi - lo);
        const u32x4 me = v[i + W2];
        float o[8];
#pragma unroll
        for (int e = 0; e < 4; ++e) { o[2 * e] = s[2 * e] * inv - bf2f(me[e] & 0xffffu); o[2 * e + 1] = s[2 * e + 1] * inv - bf2f(me[e] >> 16); }
        u32x4 w; w.x = cvt_pk_bf16(o[0], o[1]); w.y = cvt_pk_bf16(o[2], o[3]); w.z = cvt_pk_bf16(o[4], o[5]); w.w = cvt_pk_bf16(o[6], o[7]);
        *(u32x4*)(F.pd + (size_t)(tok0 + i) * 512 + col) = w;
    }
}
__device__ void pooldiff_phase(const Frame& F, int mrows) {
    const int vcp = (F.G % 8 == 0) ? (F.bid % 8) * (F.G / 8) + F.bid / 8 : F.bid;
    for (int it = vcp; it < (mrows / 256) * 4; it += F.G) {
        const int tidp = opaque_v(F.tid);
        const int gi = ((it & 3) + ((F.G & 3) == 0 ? it / F.G : 0)) & 3, tok0 = (it >> 2) * 256 + (tidp >> 4) * 8, col = gi * 128 + (tidp & 15) * 8;
        if (gi == 0) pooldiff_item<1>(F, tok0, col); else if (gi == 1) pooldiff_item<2>(F, tok0, col); else if (gi == 2) pooldiff_item<4>(F, tok0, col); else pooldiff_item<8>(F, tok0, col);
    }
}

__device__ void attn_unit(const Frame& F, int l, bool isctx, int b, int qblk, int hk) {
    const int tid = opaque_v(F.tid), lane = tid & 63, wv = tid >> 6, fr = lane & 15, fq = lane >> 4;
    const int g = wv >> 1, qh = wv & 1, hq = hk * 4 + g;
    LAS unsigned char* Kb = F.lds;
    LAS bf16_t* Vt = (LAS bf16_t*)(F.lds + 64 * 144);
    const LAS f32x2* ropeL = (const LAS f32x2*)(F.lds + 2 * 64 * 144);
    const float* qg = F.q_gain + l * 64; const float* kg = F.k_gain + l * 64;
    const int qtok0 = isctx ? ML + b * CTX + qblk * 128 + qh * 64 : b * SEQ + qblk * 128 + qh * 64;
    const int qpos0 = qblk * 128 + qh * 64;
    bf16x8 Qf[4][2];
#pragma unroll
    for (int qi = 0; qi < 4; ++qi) {
        const int tok = qtok0 + 16 * qi + fr, pos = qpos0 + 16 * qi + fr;
        float v[2][8]; float ss = 0.f;
#pragma unroll
        for (int kk = 0; kk < 2; ++kk) { const u32x4 raw = *(const u32x4*)(F.z + (size_t)tok * ZLD + hq * 64 + 32 * kk + 8 * fq);
#pragma unroll
            for (int e = 0; e < 4; ++e) { v[kk][2 * e] = bf2f(raw[e] & 0xffffu); v[kk][2 * e + 1] = bf2f(raw[e] >> 16); }
#pragma unroll
            for (int i = 0; i < 8; ++i) ss += v[kk][i] * v[kk][i]; }
        ss += __shfl_xor(ss, 16); ss += __shfl_xor(ss, 32);
        const float rstd = rsqrtf(ss * (1.0f / 64.0f) + 1e-6f);
#pragma unroll
        for (int kk = 0; kk < 2; ++kk) {
#pragma unroll
            for (int i = 0; i < 8; ++i) v[kk][i] *= rstd * qg[32 * kk + 8 * fq + i];
            if (!isctx) {
                const int p = kk ? (pos & 63) : (pos >> 6);
                const LAS f32x2* tb = ropeL + p * 16 + 8 * (fq & 1);
#pragma unroll
                for (int i = 0; i < 8; ++i) { const f32x2 cs = tb[i]; const float other = __shfl_xor(v[kk][i], 32);
                    v[kk][i] = (fq & 2) ? v[kk][i] * cs.x + other * cs.y : v[kk][i] * cs.x - other * cs.y; }
            }
            u32x4 w;
#pragma unroll
            for (int e = 0; e < 4; ++e) w[e] = cvt_pk_bf16(v[kk][2 * e] * 0.18033688f, v[kk][2 * e + 1] * 0.18033688f);
            Qf[qi][kk] = __builtin_bit_cast(bf16x8, w);
        }
    }
    float mrow[4], lrow[4];
    f32x4 O[4][4];
    const float snk = F.sink[l * 8 + hq] * 1.44269504f;
#pragma unroll
    for (int qi = 0; qi < 4; ++qi) { mrow[qi] = snk; lrow[qi] = fq == 0 ? 1.0f : 0.0f;
#pragma unroll
        for (int di = 0; di < 4; ++di) O[di][qi] = (f32x4){0.f, 0.f, 0.f, 0.f}; }
    const int jlo = isctx ? 6 : (qblk == 0 ? 2 : 0), jloc_end = isctx ? 6 : (qblk == SEQ / 128 - 1 ? 4 : 6);
    const int kr = tid >> 3, cch = tid & 7;
#define TILE_TOK0(j) ((j) < 6 ? b * SEQ + (qblk - 1) * 128 + (j) * 64 : ML + b * CTX + ((j) - 6) * 64)
#define TILE_NEXT(j) (((j) + 1 == jloc_end && jloc_end < 6) ? 6 : (j) + 1)
    u32x4 kraw, vraw;
    int j = jlo == jloc_end ? 6 : jlo;
    { const size_t tok = (size_t)(TILE_TOK0(j) + kr); kraw = *(const u32x4*)(F.z + tok * ZLD + ZK + hk * 64 + 8 * cch); vraw = *(const u32x4*)(F.z + tok * ZLD + ZV + hk * 64 + 8 * cch); }
    while (j < 10) {
        {
            float v[8]; float ss = 0.f;
#pragma unroll
            for (int e = 0; e < 4; ++e) { v[2 * e] = bf2f(kraw[e] & 0xffffu); v[2 * e + 1] = bf2f(kraw[e] >> 16); }
#pragma unroll
            for (int i = 0; i < 8; ++i) ss += v[i] * v[i];
            ss += __shfl_xor(ss, 1); ss += __shfl_xor(ss, 2); ss += __shfl_xor(ss, 4);
            const float rstd = rsqrtf(ss * (1.0f / 64.0f) + 1e-6f);
#pragma unroll
            for (int i = 0; i < 8; ++i) v[i] *= rstd * kg[8 * cch + i];
            if (j < 6) {
                const int pos = (qblk - 1) * 128 + j * 64 + kr;
                const int p = (cch & 4) ? (pos & 63) : (pos >> 6);
                const LAS f32x2* tb = ropeL + p * 16 + 8 * (cch & 1);
#pragma unroll
                for (int i = 0; i < 8; ++i) { const f32x2 cs = tb[i]; const float other = __shfl_xor(v[i], 2);
                    v[i] = (cch & 2) ? v[i] * cs.x + other * cs.y : v[i] * cs.x - other * cs.y; }
            }
            u32x4 w;
#pragma unroll
            for (int e = 0; e < 4; ++e) w[e] = cvt_pk_bf16(v[2 * e], v[2 * e + 1]);
            *(LAS u32x4*)(Kb + kr * 144 + cch * 16) = w;
#pragma unroll
            for (int e = 0; e < 4; ++e) { Vt[(8 * cch + 2 * e) * 72 + kr] = (bf16_t)(vraw[e] & 0xffffu); Vt[(8 * cch + 2 * e + 1) * 72 + kr] = (bf16_t)(vraw[e] >> 16); }
        }
        __syncthreads();
        const int jn = TILE_NEXT(j);
        if (jn < 10) { const size_t tok = (size_t)(TILE_TOK0(jn) + kr); kraw = *(const u32x4*)(F.z + tok * ZLD + ZK + hk * 64 + 8 * cch); vraw = *(const u32x4*)(F.z + tok * ZLD + ZV + hk * 64 + 8 * cch); }
        const int kpos0 = (qblk - 1) * 128 + j * 64;
        const bool local = j < 6;
        const bool active = !local || (kpos0 + 63 >= qpos0 - 128 && kpos0 <= qpos0 + 63 + 128);
        if (active) {
            const bool need_mask = local && !(kpos0 + 63 - qpos0 <= 128 && qpos0 + 63 - kpos0 <= 128);
#pragma unroll
            for (int kh = 0; kh < 2; ++kh) {
                f32x4 s[2][4];
#pragma unroll
                for (int ki = 0; ki < 2; ++ki) {
                    const bf16x8 k0 = *(const LAS bf16x8*)(Kb + (32 * kh + 16 * ki + fr) * 144 + (8 * fq) * 2);
                    const bf16x8 k1 = *(const LAS bf16x8*)(Kb + (32 * kh + 16 * ki + fr) * 144 + (32 + 8 * fq) * 2);
#pragma unroll
                    for (int qi = 0; qi < 4; ++qi) {
                        f32x4 a = __builtin_amdgcn_mfma_f32_16x16x32_bf16(k0, Qf[qi][0], (f32x4){0.f, 0.f, 0.f, 0.f}, 0, 0, 0);
                        s[ki][qi] = __builtin_amdgcn_mfma_f32_16x16x32_bf16(k1, Qf[qi][1], a, 0, 0, 0);
                    }
                }
                if (need_mask) {
#pragma unroll
                    for (int ki = 0; ki < 2; ++ki)
#pragma unroll
                        for (int qi = 0; qi < 4; ++qi)
#pragma unroll
                            for (int jj = 0; jj < 4; ++jj) { const int dk = (kpos0 + 32 * kh + 16 * ki + 4 * fq + jj) - (qpos0 + 16 * qi + fr);
                                if (dk > 128 || dk < -128) s[ki][qi][jj] = -1e30f; }
                }
                bf16x8 Pf[4];
#pragma unroll
                for (int qi = 0; qi < 4; ++qi) {
                    float mx = -1e30f;
#pragma unroll
                    for (int ki = 0; ki < 2; ++ki)
#pragma unroll
                        for (int jj = 0; jj < 4; ++jj) mx = fmaxf(mx, s[ki][qi][jj]);
                    mx = fmaxf(mx, __shfl_xor(mx, 16)); mx = fmaxf(mx, __shfl_xor(mx, 32));
                    float mn = mrow[qi], alpha = 1.0f;
                    const bool grow = __builtin_amdgcn_ballot_w64(mx > mn + 8.0f) != 0ull;
                    if (grow) { mn = fmaxf(mn, mx); alpha = __builtin_amdgcn_exp2f(mrow[qi] - mn); mrow[qi] = mn; }
                    float ps = 0.f;
#pragma unroll
                    for (int ki = 0; ki < 2; ++ki)
#pragma unroll
                        for (int jj = 0; jj < 4; ++jj) { const float p = __builtin_amdgcn_exp2f(s[ki][qi][jj] - mn); s[ki][qi][jj] = p; ps += p; }
                    lrow[qi] = lrow[qi] * alpha + ps;
                    if (grow) {
#pragma unroll
                        for (int di = 0; di < 4; ++di) O[di][qi] *= alpha; }
                    u32x4 w;
                    w.x = cvt_pk_bf16(s[0][qi][0], s[0][qi][1]); w.y = cvt_pk_bf16(s[0][qi][2], s[0][qi][3]);
                    w.z = cvt_pk_bf16(s[1][qi][0], s[1][qi][1]); w.w = cvt_pk_bf16(s[1][qi][2], s[1][qi][3]);
                    Pf[qi] = __builtin_bit_cast(bf16x8, w);
                }
#pragma unroll
                for (int di = 0; di < 4; ++di) {
                    const LAS bf16_t* vp = Vt + (16 * di + fr) * 72 + 32 * kh + 4 * fq;
                    const u32x2 a = *(const LAS u32x2*)vp, c2 = *(const LAS u32x2*)(vp + 16);
                    u32x4 w; w.x = a.x; w.y = a.y; w.z = c2.x; w.w = c2.y;
                    const bf16x8 vf = __builtin_bit_cast(bf16x8, w);
#pragma unroll
                    for (int qi = 0; qi < 4; ++qi) O[di][qi] = __builtin_amdgcn_mfma_f32_16x16x32_bf16(vf, Pf[qi], O[di][qi], 0, 0, 0);
                }
            }
        }
        __syncthreads();
        j = jn;
    }
#undef TILE_TOK0
#undef TILE_NEXT
#pragma unroll
    for (int qi = 0; qi < 4; ++qi) {
        float lt = lrow[qi]; lt += __shfl_xor(lt, 16); lt += __shfl_xor(lt, 32);
        const float il = 1.0f / lt;
        bf16_t* orow = F.at + (size_t)(qtok0 + 16 * qi + fr) * 512 + hq * 64 + 4 * fq;
#pragma unroll
        for (int di = 0; di < 4; ++di) { const f32x4 o = O[di][qi] * il; u32x2 w; w.x = cvt_pk_bf16(o[0], o[1]); w.y = cvt_pk_bf16(o[2], o[3]); *(u32x2*)(orow + 16 * di) = w; }
    }
}

__device__ void attn_phase(const Frame& F, int l, bool lastl) {
    { LAS f32x2* ropeL = (LAS f32x2*)(F.lds + 2 * 64 * 144); for (int e = opaque_v(F.tid); e < 1024; e += 512) ropeL[e] = F.rope[e]; }
    pooldiff_phase(F, lastl ? ML : MT);
    __syncthreads();
    const int nctx = lastl ? 0 : 32;
    const int vc = (F.G % 8 == 0) ? (F.bid % 8) * (F.G / 8) + F.bid / 8 : F.bid;
    for (int k = (F.bid < nctx) ? -1 : 0; ; ++k) {
        const bool isc = k < 0; const int v = isc ? F.bid : vc + k * F.G;
        if (!isc && v >= 512) break;
        attn_unit(F, l, isc, isc ? (v >> 2) : (v >> 6), isc ? ((v >> 1) & 1) : ((v >> 1) & 31), v & 1);
    }
}

__device__ void fixup_phase(const Frame& F, int l, int ngrp, bf16_t* act) {
    const float* cw = F.conv_w + (size_t)l * 3 * UPW; const float* cb = F.conv_b + (size_t)l * UPW;
    const int tidf = opaque_v(F.tid);
    for (int idx = F.bid * 512 + tidf; idx < ngrp * 2 * 704; idx += F.G * 512) {
        const int c4 = idx % 704, rb = idx / 704, grp = rb >> 1, bot = rb & 1, ch = c4 * 4;
        bool edge;
        if (grp < 256) edge = bot ? ((grp & 31) == 31) : ((grp & 31) == 0); else edge = bot ? (((grp - 256) & 1) == 1) : (((grp - 256) & 1) == 0);
        const float* U = F.ub;
#define UB(g_, s_, h_) (*(const f32x4*)(U + ((size_t)((g_) * 4 + (s_)) * 2 + (h_)) * DFF + ch))
        f32x4 pa, pb, ca, cbv, na, nb; const f32x4 zero = (f32x4){0.f, 0.f, 0.f, 0.f};
        if (!bot) { ca = UB(grp, 0, 0); cbv = UB(grp, 0, 1); na = UB(grp, 1, 0); nb = UB(grp, 1, 1);
            if (edge) { pa = zero; pb = zero; } else { pa = UB(grp - 1, 3, 0); pb = UB(grp - 1, 3, 1); } }
        else { ca = UB(grp, 3, 0); cbv = UB(grp, 3, 1); pa = UB(grp, 2, 0); pb = UB(grp, 2, 1);
            if (edge) { na = zero; nb = zero; } else { na = UB(grp + 1, 0, 0); nb = UB(grp + 1, 0, 1); } }
#undef UB
        const f32x4 ua = *(const f32x4*)(cb + ch) + *(const f32x4*)(cw + ch) * pa + *(const f32x4*)(cw + UPW + ch) * ca + *(const f32x4*)(cw + 2 * UPW + ch) * na;
        const f32x4 uv = *(const f32x4*)(cb + DFF + ch) + *(const f32x4*)(cw + DFF + ch) * pb + *(const f32x4*)(cw + UPW + DFF + ch) * cbv + *(const f32x4*)(cw + 2 * UPW + DFF + ch) * nb;
        float o[4];
#pragma unroll
        for (int j2 = 0; j2 < 4; ++j2) o[j2] = ua[j2] * sigmoidf_(ua[j2]) * uv[j2];
        u32x2 w; w.x = cvt_pk_bf16(o[0], o[1]); w.y = cvt_pk_bf16(o[2], o[3]);
        *(u32x2*)(act + (size_t)(grp * 128 + (bot ? 127 : 0)) * DFF + ch) = w;
    }
}


#define XB_TMO      128
#define XB_XCNT(j)  (256  + 64 * (j))
#define XB_XSUB(j)  (1280 + 64 * (j))
#define XB_XGEN(j)  (2304 + 64 * (j))
#define XB_TOP      3328
#define XB_TOPGEN   3392
#define XCD_BAR_WORDS 3456
#define XB_SPIN_CAP (1u << 18)
__device__ __forceinline__ unsigned xb_ld(unsigned* p)              { return __hip_atomic_load(p, __ATOMIC_RELAXED, __HIP_MEMORY_SCOPE_AGENT); }
__device__ __forceinline__ unsigned xb_add(unsigned* p, unsigned v) { return __hip_atomic_fetch_add(p, v, __ATOMIC_RELAXED, __HIP_MEMORY_SCOPE_AGENT); }
__device__ __forceinline__ unsigned xb_xcc_id() { return (unsigned)__builtin_amdgcn_s_getreg((3 << 11) | 20) & 0xFu; }
#define XB_SPIN(cond, bar) do { unsigned _sp = 0; while (cond) { __builtin_amdgcn_s_sleep(1); \
    if ((++_sp & 255u) == 0u) { if (xb_ld(&(bar)[XB_TMO])) break; if (_sp > XB_SPIN_CAP) { atomicAdd(&(bar)[XB_TMO], 1u); break; } } } } while (0)
struct XcdBarrier { unsigned* bar; unsigned x; volatile LAS unsigned* st; };
__device__ __forceinline__ XcdBarrier xcd_barrier_post(unsigned* bar, volatile LAS unsigned* st) {
    XcdBarrier b; b.bar = bar; b.x = xb_xcc_id(); b.st = st;
    if (threadIdx.x == 0) (void)xb_add(&bar[XB_XCNT(b.x)], 1u);
    return b;
}
__device__ __forceinline__ void xcd_barrier_complete(unsigned* bar, unsigned x, unsigned& nloc, unsigned& nx) {
    const unsigned G = gridDim.x * gridDim.y * gridDim.z;
    unsigned sum, cnt, mine, sp = 0u;
    for (;;) {
        sum = 0u; cnt = 0u; mine = 0u;
#pragma unroll
        for (unsigned j = 0; j < 16; ++j) { const unsigned c = xb_ld(&bar[XB_XCNT(j)]); sum += c; cnt += (c > 0u) ? 1u : 0u; mine = (j == x) ? c : mine; }
        if (sum == G) break;
        __builtin_amdgcn_s_sleep(1);
        if ((++sp & 255u) == 0u) { if (xb_ld(&bar[XB_TMO])) break; if (sp > XB_SPIN_CAP) { atomicAdd(&bar[XB_TMO], 1u); break; } }
    }
    nloc = mine > 0u ? mine : 1u; nx = cnt > 0u ? cnt : 1u;
}
__device__ __forceinline__ void xcd_barrier(const XcdBarrier& b, int wid) {
    asm volatile("s_waitcnt vmcnt(0)" ::: "memory");
    __syncthreads();
    if (fresh_tid(wid) == 0) {
        unsigned* bar = b.bar;
        __builtin_amdgcn_s_waitcnt(0);
        unsigned nloc = b.st[0], nx = b.st[1];
        if (nloc == 0u) { xcd_barrier_complete(bar, b.x, nloc, nx); b.st[0] = nloc; b.st[1] = nx; }
        const unsigned old = xb_add(&bar[XB_XSUB(b.x)], 1u);
        const unsigned gen = old / nloc;
        if (old + 1u == (gen + 1u) * nloc) {
            __builtin_amdgcn_fence(__ATOMIC_RELEASE, "agent");
            asm volatile("s_waitcnt vmcnt(0)" ::: "memory");
            const unsigned og = xb_add(&bar[XB_TOP], 1u);
            const unsigned tg = og / nx;
            if (og + 1u == (tg + 1u) * nx) xb_add(&bar[XB_TOPGEN], 1u);
            else XB_SPIN(xb_ld(&bar[XB_TOPGEN]) == tg, bar);
            __builtin_amdgcn_fence(__ATOMIC_ACQUIRE, "agent");
            xb_add(&bar[XB_XGEN(b.x)], 1u);
            asm volatile("s_waitcnt vmcnt(0)" ::: "memory");
        } else {
            XB_SPIN(xb_ld(&bar[XB_XGEN(b.x)]) == gen, bar);
            __builtin_amdgcn_fence(__ATOMIC_ACQUIRE, "agent");
            asm volatile("s_waitcnt vmcnt(0)" ::: "memory");
        }
    }
    __syncthreads();
}

__device__ __forceinline__ void sched_init(pg8::Sched& S, const Frame& F, int M, int N, int K, const void* A0, const void* B0, const void* A1, const void* B1, int pshift) {
    S.nM = M / 256; S.nN = N / 256; S.nwg = S.nM * S.nN; S.G = F.G; S.c = F.bid; S.pshift = pshift; S.nt = K / 64; S.split = 0;
    S.A0 = (const char*)A0; S.A1 = (const char*)A1; S.B0 = (const char*)B0; S.B1 = (const char*)B1; S.tstepA = (size_t)256 * K * 2; S.tstepB = (size_t)256 * K * 2;
}

__global__ void __launch_bounds__(512, 2) mega(Args a) {
    extern __shared__ __attribute__((aligned(16))) unsigned char shm[];
    volatile LAS unsigned* bst = (volatile LAS unsigned*)((LAS unsigned char*)shm + pg8::STAGE_BYTES);
    const int wid_s = __builtin_amdgcn_readfirstlane((int)(threadIdx.x >> 6));
    if (threadIdx.x == 0) { bst[0] = 0u; bst[1] = 0u; }
    __syncthreads();
    XcdBarrier xbar; xbar.bar = nullptr; xbar.x = 0; xbar.st = bst;
    if (!MULTI_LAUNCH) xbar = xcd_barrier_post((unsigned*)(a.ws + WS_BAR), bst);
    for (int ph = a.ph_lo; ph < a.ph_hi; ++ph) {
        if (ph > a.ph_lo) { if (ph == a.ph_lo + 1) cg::this_grid().sync(); else xcd_barrier(xbar, wid_s); }
        typedef const __attribute__((address_space(4))) Args* KArgsP;
        KArgsP ka = (KArgsP)__builtin_amdgcn_kernarg_segment_ptr();
        asm volatile("" : "+s"(ka));
        Frame F;
        F.x = ka->in[0]; F.c = ka->in[1]; F.ctx = ka->in[2]; F.c_ctx = ka->in[3]; F.w_mod = ka->in[4]; F.b_mod = ka->in[5]; F.norm1_g = ka->in[6]; F.norm2_g = ka->in[7]; F.w_in = ka->in[8];
        F.q_gain = ka->in[9]; F.k_gain = ka->in[10]; F.sink = ka->in[11]; F.w_pool = ka->in[12]; F.pool_scale = ka->in[13]; F.w_br_attn = ka->in[14]; F.w_br_pool = ka->in[15]; F.w_out = ka->in[16];
        F.w_up = ka->in[17]; F.conv_w = ka->in[18]; F.conv_b = ka->in[19]; F.w_down = ka->in[20];
        F.out = ka->out; F.ws = ka->ws;
        F.mod = (float*)(F.ws + WS_MOD); F.rope = (f32x2*)(F.ws + WS_ROPE); F.h = (bf16_t*)(F.ws + WS_H); F.xc = (float*)(F.ws + WS_XC); F.z = (bf16_t*)(F.ws + WS_Z);
        F.at = (bf16_t*)(F.ws + WS_AT); F.pd = (bf16_t*)(F.ws + WS_PD); F.ub = (float*)(F.ws + WS_AT);
        F.lds = (LAS unsigned char*)shm; F.tid = wid_s;     F.G = gridDim.x; F.bid = blockIdx.x;
        bf16_t* const act = F.z;
        bf16_t* const ybuf = F.h;

        if (ph == 0) { if (PHM & 512) prologue(F); continue; }
        const int l = (ph - 1) / PPL, vs = (ph - 1) % PPL, s = (DUPS >= 0 && vs > DUPS) ? vs - 1 : vs; const bool lastl = l == DEPTH - 1;
        const float* xl_in = l == 0 ? F.x : F.out; const float* xc_in = l == 0 ? F.ctx : F.xc;
        const float* modl = F.mod + (size_t)l * 9 * NMOD;
        const unsigned char* wl = F.ws + WS_W + (size_t)l * SZ_WL;
        const int Mg = lastl ? ML : MT;
        pg8::Sched S;
        const int usp = (F.G == 256 && !lastl) ? 1 : 0;
        float* const Pz = (float*)F.z;
        float* const Pt = (float*)(F.ws + WS_Z + (size_t)MT * DFF * 2);
        if (s == 0) norm_phase(F, xl_in, xc_in, F.norm1_g + l * D, modl, 0, D, (l > 0 && F.G == 256) ? Pt : nullptr);
        else if (s == 1) { sched_init(S, F, MT, INW, D, F.h, wl + OFF_WIN, F.h, wl + OFF_WIN, 0); pg8::EpiZ E{F.z}; pg8::gemm_phase<pg8::EpiZ, false>(F.lds, F.tid, D, S, E); }
        else if (s == 2) attn_phase(F, l, lastl);
        else if (s == 3) { sched_init(S, F, Mg, D, 512, F.at, wl + OFF_WA, F.pd, wl + OFF_WE, 1); pg8::EpiMerge E{F.z, ybuf}; pg8::gemm_phase<pg8::EpiMerge, false>(F.lds, F.tid, 512, S, E); }
        else if (s == 4) { sched_init(S, F, usp ? ML : Mg, D, D, ybuf, wl + OFF_WO, ybuf, wl + OFF_WO, 0); S.split = usp;
            pg8::EpiRes E{xl_in, xc_in, F.out, F.xc, modl, Pz, 2 * D}; pg8::gemm_phase<pg8::EpiRes, false>(F.lds, F.tid, D, S, E); }
        else if (s == 5) norm_phase(F, F.out, (usp && l == 0) ? F.ctx : F.xc, F.norm2_g + l * D, modl, 3 * D, 4 * D, usp ? Pz : nullptr);
        else if (s == 6) { sched_init(S, F, Mg, UPW, D, F.h, wl + OFF_WU, F.h, wl + OFF_WU, 0); pg8::EpiUp E{act, F.ub, F.conv_w + (size_t)l * 3 * UPW, F.conv_b + (size_t)l * UPW}; pg8::gemm_phase<pg8::EpiUp, true>(F.lds, F.tid, D, S, E); }
        else if (s == 7) fixup_phase(F, l, Mg / 128, act);
        else { sched_init(S, F, usp ? ML : Mg, D, DFF, act, wl + OFF_WD, act, wl + OFF_WD, 0); S.split = usp;
            pg8::EpiRes E{F.out, F.xc, F.out, F.xc, modl, Pt, 5 * D}; pg8::gemm_phase<pg8::EpiRes, false>(F.lds, F.tid, DFF, S, E); }
    }
}

extern "C" void kernel_launch(void* const* d_in, const int* in_sizes, int n_in, void* d_out, int out_size, void* d_ws, size_t ws_size, hipStream_t stream) {
    constexpr int LDS_BYTES = pg8::STAGE_BYTES + 256;
    static int grid = 0;
    if (grid == 0) {
        if (n_in != 21 || ws_size < WS_TOTAL) { fprintf(stderr, "kernel_launch: unexpected n_in %d / ws %zu (need %zu)\n", n_in, ws_size, (size_t)WS_TOTAL); grid = -1; return; }
        int dev = 0, cus = 0, per_cu = 0;
        hipGetDevice(&dev); hipDeviceGetAttribute(&cus, hipDeviceAttributeMultiprocessorCount, dev);
        if (hipFuncSetAttribute((const void*)mega, hipFuncAttributeMaxDynamicSharedMemorySize, LDS_BYTES) != hipSuccess) { fprintf(stderr, "kernel_launch: hipFuncSetAttribute failed\n"); grid = -1; return; }
        if (hipOccupancyMaxActiveBlocksPerMultiprocessor(&per_cu, (const void*)mega, 512, LDS_BYTES) != hipSuccess || per_cu < 1) { fprintf(stderr, "kernel_launch: occupancy query says %d\n", per_cu); per_cu = 1; }
        (void)hipGetLastError();
        grid = cus * 1;
    }
    if (grid < 0) return;
    Args a{};
    for (int i = 0; i < 21; ++i) a.in[i] = (const float*)d_in[i];
    a.out = (float*)d_out; a.ws = (unsigned char*)d_ws;
#if !MULTI_LAUNCH
    if (hipMemsetAsync((char*)d_ws + WS_BAR, 0, XCD_BAR_WORDS * 4, stream) != hipSuccess) { fprintf(stderr, "kernel_launch: memset failed\n"); return; }
#endif
#if MULTI_LAUNCH
    for (int ph = 0; ph < NPHASE; ++ph) { a.ph_lo = ph; a.ph_hi = ph + 1; hipLaunchKernelGGL(mega, dim3(grid), dim3(512), LDS_BYTES, stream, a); }
#else
    a.ph_lo = 0; a.ph_hi = NPHASE;
    void* args[] = {&a};
    hipError_t e = hipLaunchCooperativeKernel((const void*)mega, dim3(grid), dim3(512), args, LDS_BYTES, stream);
    if (e != hipSuccess) fprintf(stderr, "cooperative launch failed: %s (grid %d)\n", hipGetErrorString(e), grid);
#endif
}
```
